# Optimizing an MI355X kernel written in HIP

```python
import jax
import jax.numpy as jnp
from jax import lax
import numpy as np

D_MODEL = 1024
BATCH = 4
SEQ = 4096
DEPTH = 2

GRID_W = 64
RMS_EPS = 1e-6

NA_HEADS = 8
NA_HEAD_DIM = 64
NA_WIDTH = NA_HEADS * NA_HEAD_DIM
NA_KR = 8
NA_KC = 16
NA_QC = 16
NA_KCB = 2 * NA_QC
NA_NCB = GRID_W // NA_QC

FN_GROUPS = 8
FN_GROUP_DIM = 64
FN_WIDTH = FN_GROUPS * FN_GROUP_DIM

EVEN_IN = 3 * NA_WIDTH + FN_WIDTH
EVEN_MIX = NA_WIDTH + FN_WIDTH

ML_HEADS = 8
ML_QK_DIM = 64
ML_V_DIM = 128
ML_QK_WIDTH = ML_HEADS * ML_QK_DIM
ML_WIDTH = ML_HEADS * ML_V_DIM
ML_CHUNK = 64
ODD_IN = 2 * ML_QK_WIDTH + 2 * ML_WIDTH + 4 * ML_HEADS

MOE_GROUPS = 4
MOE_EXPERTS_PER_GROUP = 8
MOE_EXPERTS = MOE_GROUPS * MOE_EXPERTS_PER_GROUP
MOE_TOP_K = 2
MOE_FF = 512
MOE_BLOCK = 256

N_EVEN = (DEPTH + 1) // 2
N_ODD = DEPTH // 2

kernel_name = 'hybrid_natten_fnet_mlstm_hmoe_encoder'


def rms_norm(x, gain):
    xf = x.astype(jnp.float32)
    y = xf * lax.rsqrt(jnp.mean(xf * xf, axis=-1, keepdims=True) + RMS_EPS)
    return (y * gain.astype(jnp.float32)).astype(x.dtype)


def neighbourhood_attention(q, k, v, rel_bias):
    B, S, H, dh = q.shape
    rows = S // GRID_W
    kr = min(NA_KR, rows)
    r = jnp.arange(rows)
    row_idx = jnp.clip(r - kr // 2, 0, rows - kr)[:, None] + jnp.arange(kr)[None, :]
    qcol = jnp.arange(GRID_W).reshape(NA_NCB, NA_QC)
    blk_start = jnp.clip(qcol[:, 0] - NA_KC // 2, 0, GRID_W - NA_KCB)
    col_idx = blk_start[:, None] + jnp.arange(NA_KCB)[None, :]
    win_start = jnp.clip(qcol - NA_KC // 2, 0, GRID_W - NA_KC)
    kcol = col_idx[:, None, :]
    col_valid = (kcol >= win_start[..., None]) & (kcol < win_start[..., None] + NA_KC)
    dr = row_idx - r[:, None] + (NA_KR - 1)
    dc = jnp.clip(kcol - qcol[..., None] + (NA_KC - 1), 0, 2 * NA_KC - 2)
    bias = rel_bias.astype(jnp.float32)[:, dr[:, None, None, :, None], dc[None, :, :, None, :]]

    def gather_block(t):
        tg = t.reshape(B, rows, GRID_W, H, dh)
        return jnp.take(jnp.take(tg, row_idx, axis=1), col_idx, axis=3)

    kg = gather_block(k)
    vg = gather_block(v)
    qg = q.reshape(B, rows, NA_NCB, NA_QC, H, dh)
    s = jnp.einsum('brjqhd,brajchd->bhrjqac', qg, kg).astype(jnp.float32) * (dh ** -0.5) + bias[None]
    s = jnp.where(col_valid[:, :, None, :], s, -jnp.inf)
    p = jax.nn.softmax(s.reshape(*s.shape[:-2], kr * NA_KCB), axis=-1).reshape(s.shape)
    o = jnp.einsum('bhrjqac,brajchd->brjqhd', p.astype(v.dtype), vg)
    return o.reshape(B, S, H * dh)


def fourier_mix(u):
    B, S, _ = u.shape
    uf = u.astype(jnp.float32).reshape(B, S, FN_GROUPS, FN_GROUP_DIM)
    z = jnp.fft.fft2(uf, axes=(1, 3), norm='ortho').real
    return z.reshape(B, S, FN_WIDTH).astype(u.dtype)


def even_mixer(xn, w_in, q_gain, k_gain, rel_bias, w_out):
    B, S, _ = xn.shape
    u = xn @ w_in
    q, k, v, ub = jnp.split(u, [NA_WIDTH, 2 * NA_WIDTH, 3 * NA_WIDTH], axis=-1)
    heads = lambda t: t.reshape(B, S, NA_HEADS, NA_HEAD_DIM)
    q = rms_norm(heads(q), q_gain)
    k = rms_norm(heads(k), k_gain)
    a = neighbourhood_attention(q, k, heads(v), rel_bias)
    b = fourier_mix(ub)
    return jnp.concatenate([a, b], axis=-1) @ w_out


def mlstm_chunkwise(q, k, v, log_i, log_f):
    B, H, S, dk = q.shape
    dv = v.shape[-1]
    L = ML_CHUNK
    nc = S // L
    q = q.reshape(B, H, nc, L, dk)
    k = k.reshape(B, H, nc, L, dk)
    v = v.reshape(B, H, nc, L, dv)
    log_i = log_i.reshape(B, H, nc, L)
    b = jnp.cumsum(log_f.reshape(B, H, nc, L), axis=-1)
    g = b[..., -1]
    w_log = g[..., None] - b + log_i
    m_loc = jnp.max(w_log, axis=-1)
    w = jnp.exp(w_log - m_loc[..., None])
    dC = jnp.einsum('bhcl,bhcld,bhcle->bhcde', w, k, v)
    dn = jnp.einsum('bhcl,bhcld->bhcd', w, k)

    def step(carry, xs):
        C, n, m = carry
        g_c, dC_c, dn_c, ml_c = xs
        m_new = jnp.maximum(g_c + m, ml_c)
        a = jnp.exp(g_c + m - m_new)
        c = jnp.exp(ml_c - m_new)
        C_new = a[..., None, None] * C + c[..., None, None] * dC_c
        n_new = a[..., None] * n + c[..., None] * dn_c
        return (C_new, n_new, m_new), (C, n, m)

    init = (jnp.zeros((B, H, dk, dv), jnp.float32), jnp.zeros((B, H, dk), jnp.float32),
            jnp.zeros((B, H), jnp.float32))
    xs = (jnp.moveaxis(g, 2, 0), jnp.moveaxis(dC, 2, 0), jnp.moveaxis(dn, 2, 0), jnp.moveaxis(m_loc, 2, 0))
    _, (C_prev, n_prev, m_prev) = lax.scan(step, init, xs)
    C_prev = jnp.moveaxis(C_prev, 0, 2)
    n_prev = jnp.moveaxis(n_prev, 0, 2)
    m_prev = jnp.moveaxis(m_prev, 0, 2)

    tril = jnp.tril(jnp.ones((L, L), dtype=bool))
    d_log = jnp.where(tril, b[..., :, None] - b[..., None, :] + log_i[..., None, :], -jnp.inf)
    inter_log = b + m_prev[..., None]
    m_out = jnp.maximum(inter_log, jnp.max(d_log, axis=-1))
    d_w = jnp.exp(d_log - m_out[..., None])
    inter_w = jnp.exp(inter_log - m_out)
    s = jnp.einsum('bhcld,bhcsd->bhcls', q, k) * d_w
    num = jnp.einsum('bhcls,bhcse->bhcle', s, v) + inter_w[..., None] * jnp.einsum('bhcld,bhcde->bhcle', q, C_prev)
    den = jnp.sum(s, axis=-1) + inter_w * jnp.einsum('bhcld,bhcd->bhcl', q, n_prev)
    h = num / jnp.maximum(jnp.abs(den), jnp.exp(-m_out))[..., None]
    return h.reshape(B, H, S, dv)


def odd_mixer(xn, w_in, gate_bias, h_gain, w_out):
    B, S, _ = xn.shape
    u = xn @ w_in
    q, k, v, o, gates = jnp.split(
        u, [ML_QK_WIDTH, 2 * ML_QK_WIDTH, 2 * ML_QK_WIDTH + ML_WIDTH, 2 * ML_QK_WIDTH + 2 * ML_WIDTH], axis=-1)
    to_heads = lambda t, d: t.reshape(B, S, ML_HEADS, d).transpose(0, 2, 1, 3).astype(jnp.float32)
    q = to_heads(q, ML_QK_DIM)
    k = to_heads(k, ML_QK_DIM) * (ML_QK_DIM ** -0.5)
    v = to_heads(v, ML_V_DIM)
    gates = (gates.astype(jnp.float32) + gate_bias.astype(jnp.float32)).reshape(B, S, 4, ML_HEADS)
    gates = gates.transpose(2, 0, 3, 1)
    i_fw, f_fw, i_bw, f_bw = gates[0], gates[1], gates[2], gates[3]
    h_fw = mlstm_chunkwise(q, k, v, i_fw, jax.nn.log_sigmoid(f_fw))
    rev = lambda t: jnp.flip(t, axis=2)
    h_bw = rev(mlstm_chunkwise(rev(q), rev(k), rev(v), rev(i_bw), jax.nn.log_sigmoid(rev(f_bw))))
    h = (h_fw + h_bw).transpose(0, 2, 1, 3)
    h = rms_norm(h, h_gain.reshape(ML_HEADS, ML_V_DIM)).reshape(B, S, ML_WIDTH)
    h = h * jax.nn.sigmoid(o.astype(jnp.float32))
    return h.astype(xn.dtype) @ w_out


def hier_route(x2, w_rg, b_rg, w_re, b_re):
    T = x2.shape[0]
    pg = jax.nn.softmax((x2 @ w_rg).astype(jnp.float32) + b_rg.astype(jnp.float32), axis=-1)
    p_top, g_sel = lax.top_k(pg, 1)
    le = ((x2 @ w_re).astype(jnp.float32) + b_re.astype(jnp.float32)).reshape(T, MOE_GROUPS, MOE_EXPERTS_PER_GROUP)
    le_sel = le[jnp.arange(T), g_sel[:, 0]]
    pe = jax.nn.softmax(le_sel, axis=-1)
    v2, i2 = lax.top_k(pe, MOE_TOP_K)
    gate = p_top * v2 / jnp.sum(v2, axis=-1, keepdims=True)
    eid = g_sel * MOE_EXPERTS_PER_GROUP + i2
    return eid.astype(jnp.int32), gate


def expert_mix(x2, eid, gate, w_gate, w_up, w_down):
    T, D = x2.shape
    A = T * MOE_TOP_K
    n_blocks = (A + MOE_EXPERTS * (MOE_BLOCK - 1) + MOE_BLOCK - 1) // MOE_BLOCK
    P = n_blocks * MOE_BLOCK
    flat_e = eid.reshape(-1)
    flat_tok = jnp.broadcast_to(jnp.arange(T, dtype=jnp.int32)[:, None], (T, MOE_TOP_K)).reshape(-1)
    flat_g = gate.reshape(-1)
    order = jnp.argsort(flat_e)
    se, stok, sg = flat_e[order], flat_tok[order], flat_g[order]
    counts = jax.ops.segment_sum(jnp.ones((A,), jnp.int32), flat_e, num_segments=MOE_EXPERTS)
    starts = jnp.cumsum(counts) - counts
    padded = (counts + MOE_BLOCK - 1) // MOE_BLOCK * MOE_BLOCK
    pend = jnp.cumsum(padded)
    pstarts = pend - padded
    dest = pstarts[se] + (jnp.arange(A, dtype=jnp.int32) - starts[se])
    row_tok = jnp.full((P,), T, jnp.int32).at[dest].set(stok)
    row_gate = jnp.zeros((P,), jnp.float32).at[dest].set(sg)
    block_start = jnp.arange(n_blocks, dtype=jnp.int32) * MOE_BLOCK
    block_e = jnp.minimum(jnp.searchsorted(pend, block_start, side='right'), MOE_EXPERTS - 1)
    x_pad = jnp.concatenate([x2, jnp.zeros((1, D), x2.dtype)], axis=0)

    def block_fn(args):
        rows, e = args
        xb = x_pad[rows]
        h = jax.nn.silu(xb @ w_gate[e]) * (xb @ w_up[e])
        return h @ w_down[e]

    y_rows = lax.map(block_fn, (row_tok.reshape(n_blocks, MOE_BLOCK), block_e))
    y = jnp.zeros((T + 1, D), jnp.float32).at[row_tok].add(
        y_rows.reshape(P, D).astype(jnp.float32) * row_gate[:, None])
    return y[:T].astype(x2.dtype)


def hier_moe(xn, w_rg, b_rg, w_re, b_re, w_gate, w_up, w_down):
    B, S, D = xn.shape
    x2 = xn.reshape(B * S, D)
    eid, gate = hier_route(x2, w_rg, b_rg, w_re, b_re)
    return expert_mix(x2, eid, gate, w_gate, w_up, w_down).reshape(B, S, D)


def setup_inputs(seed: int = 0) -> dict:
    key = jax.random.key(seed)
    ks = jax.random.split(key, 21)
    nrm = lambda k, shape, scale: scale * jax.random.normal(k, shape, jnp.float32)
    gate_base = jnp.asarray([0.0, 3.0, 0.0, 3.0], jnp.float32)[None, :, None]
    od_gate_bias = (gate_base + nrm(ks[9], (N_ODD, 4, ML_HEADS), 0.1)).reshape(N_ODD, 4 * ML_HEADS)
    return {
        'x': nrm(ks[0], (BATCH, SEQ, D_MODEL), 1.0),
        'ev_norm': 1.0 + nrm(ks[1], (N_EVEN, D_MODEL), 0.05),
        'ev_w_in': nrm(ks[2], (N_EVEN, D_MODEL, EVEN_IN), D_MODEL ** -0.5),
        'ev_q_gain': 1.0 + nrm(ks[3], (N_EVEN, NA_HEAD_DIM), 0.05),
        'ev_k_gain': 1.0 + nrm(ks[4], (N_EVEN, NA_HEAD_DIM), 0.05),
        'ev_rel_bias': nrm(ks[5], (N_EVEN, NA_HEADS, 2 * NA_KR - 1, 2 * NA_KC - 1), 0.1),
        'ev_w_out': nrm(ks[6], (N_EVEN, EVEN_MIX, D_MODEL), EVEN_MIX ** -0.5),
        'od_norm': 1.0 + nrm(ks[7], (N_ODD, D_MODEL), 0.05),
        'od_w_in': nrm(ks[8], (N_ODD, D_MODEL, ODD_IN), D_MODEL ** -0.5),
        'od_gate_bias': od_gate_bias,
        'od_h_gain': 1.0 + nrm(ks[10], (N_ODD, ML_WIDTH), 0.05),
        'od_w_out': nrm(ks[11], (N_ODD, ML_WIDTH, D_MODEL), ML_WIDTH ** -0.5),
        'moe_norm': 1.0 + nrm(ks[12], (DEPTH, D_MODEL), 0.05),
        'moe_w_rg': nrm(ks[13], (DEPTH, D_MODEL, MOE_GROUPS), D_MODEL ** -0.5),
        'moe_b_rg': nrm(ks[14], (DEPTH, MOE_GROUPS), 0.01),
        'moe_w_re': nrm(ks[15], (DEPTH, D_MODEL, MOE_EXPERTS), D_MODEL ** -0.5),
        'moe_b_re': nrm(ks[16], (DEPTH, MOE_EXPERTS), 0.01),
        'moe_w_gate': nrm(ks[17], (DEPTH, MOE_EXPERTS, D_MODEL, MOE_FF), D_MODEL ** -0.5),
        'moe_w_up': nrm(ks[18], (DEPTH, MOE_EXPERTS, D_MODEL, MOE_FF), D_MODEL ** -0.5),
        'moe_w_down': nrm(ks[19], (DEPTH, MOE_EXPERTS, MOE_FF, D_MODEL), MOE_FF ** -0.5),
    }


def reference(x, ev_norm, ev_w_in, ev_q_gain, ev_k_gain, ev_rel_bias, ev_w_out,
              od_norm, od_w_in, od_gate_bias, od_h_gain, od_w_out,
              moe_norm, moe_w_rg, moe_b_rg, moe_w_re, moe_b_re, moe_w_gate, moe_w_up, moe_w_down):
    for layer in range(DEPTH):
        i = layer // 2
        if layer % 2 == 0:
            x = x + even_mixer(rms_norm(x, ev_norm[i]), ev_w_in[i], ev_q_gain[i], ev_k_gain[i],
                               ev_rel_bias[i], ev_w_out[i])
        else:
            x = x + odd_mixer(rms_norm(x, od_norm[i]), od_w_in[i], od_gate_bias[i], od_h_gain[i], od_w_out[i])
        x = x + hier_moe(rms_norm(x, moe_norm[layer]), moe_w_rg[layer], moe_b_rg[layer], moe_w_re[layer],
                         moe_b_re[layer], moe_w_gate[layer], moe_w_up[layer], moe_w_down[layer])
    return x
```

```cpp
#include <hip/hip_runtime.h>
#include <cstdio>
#include <cstdint>

#define GAS __attribute__((address_space(1)))
#define LAS __attribute__((address_space(3)))
typedef unsigned short bf16;
typedef unsigned v4u __attribute__((ext_vector_type(4)));
typedef unsigned v2u __attribute__((ext_vector_type(2)));
typedef float f32x4 __attribute__((ext_vector_type(4)));
typedef float f32x2 __attribute__((ext_vector_type(2)));
typedef short bf16x8 __attribute__((ext_vector_type(8)));
typedef GAS unsigned gu32;

#ifndef PROBE_REP
#define PROBE_REP 0u
#endif
#ifndef MK_PER_PHASE
#define MK_PER_PHASE 0
#endif

constexpr int NB = 4, SEQ = 4096, T = NB * SEQ, D = 1024;
constexpr int EV_IN = 2048, OD_IN = 3104, OD_INP = 3072;
constexpr int PU = EV_IN + 32;
constexpr int NE = 32, FF = 512;
constexpr int PQK = 1024 + 32, PVO = 2048 + 32;
constexpr size_t VO_OFF = (size_t)T * PQK;
constexpr float RMS_EPS = 1e-6f;
constexpr int NPH = 18;

constexpr size_t MiB = 1u << 20;
constexpr size_t WS_CTL = 0, CTL_ZERO_BYTES = 1 * MiB;
constexpr size_t WS_WEVIN = 1 * MiB, WS_WEVOUT = 5 * MiB, WS_WODIN = 7 * MiB, WS_WODOUT = 13 * MiB;
constexpr size_t WS_ROUTE = 15 * MiB;
constexpr size_t WS_GATES = 16 * MiB;
constexpr size_t WS_LIST = 18 * MiB;
constexpr size_t WS_SC = 20 * MiB;
constexpr size_t WS_WR = 20 * MiB + 512 * 1024;
constexpr size_t WS_WGT = WS_WR + 2 * 48 * 1024 * 2;
constexpr size_t WS_DN = 21 * MiB, WS_NPREV = 22 * MiB;
constexpr size_t WS_WG = 24 * MiB, WS_WU = 56 * MiB, WS_WD = 88 * MiB;
constexpr size_t WS_XN = 120 * MiB;
constexpr size_t WS_X1 = 153 * MiB;
constexpr size_t WS_U = 217 * MiB;
constexpr size_t WS_MIX = 313 * MiB;
constexpr size_t WS_Y = 217 * MiB;
constexpr size_t WS_H = 297 * MiB;
constexpr size_t WS_DC = 345 * MiB;
constexpr size_t WS_CP = 409 * MiB;
constexpr size_t WS_Y2 = 474 * MiB;
constexpr size_t WS_END = 508 * MiB;

constexpr int CW_BAR = 4096;
constexpr int CW_CNT = 16384;
constexpr int CW_QHEAD = 40960;
constexpr int CW_QDENSE = 45056;
constexpr int CW_DONE = 49152;

constexpr int RING_BYTES = 131072, LDSCTL_OFF = RING_BYTES, MISC_OFF = LDSCTL_OFF + 320, LDS_BYTES = 147456;

#define RLX_AGENT __ATOMIC_RELAXED, __HIP_MEMORY_SCOPE_AGENT
#define LDS_WAIT() asm volatile("s_waitcnt lgkmcnt(0)" ::: "memory")
#define VM_WAIT() asm volatile("s_waitcnt vmcnt(0)" ::: "memory")

__device__ __forceinline__ unsigned f2bf(float f) { unsigned u = __builtin_bit_cast(unsigned, f); return (u + 0x7fffu + ((u >> 16) & 1u)) >> 16; }
__device__ __forceinline__ unsigned pk2(float lo, float hi) { return f2bf(lo) | (f2bf(hi) << 16); }
__device__ __forceinline__ float bf2f(unsigned short b) { return __builtin_bit_cast(float, ((unsigned)b) << 16); }
__device__ __forceinline__ float bflo(unsigned w) { return __builtin_bit_cast(float, w << 16); }
__device__ __forceinline__ float bfhi(unsigned w) { return __builtin_bit_cast(float, w & 0xffff0000u); }
__device__ __forceinline__ float shf(float v, int src) { return __builtin_bit_cast(float, __builtin_amdgcn_ds_bpermute(src << 2, __builtin_bit_cast(int, v))); }
__device__ __forceinline__ int shfi(int v, int src) { return __builtin_amdgcn_ds_bpermute(src << 2, v); }
__device__ __forceinline__ float shx(float v, int mask, int lane) { return shf(v, lane ^ mask); }
__device__ __forceinline__ float shup(float v, int d, int lane) { return shf(v, lane >= d ? lane - d : lane); }
#define MK_DPPF(idv, x, ctrl, rmask) __builtin_bit_cast(float, __builtin_amdgcn_update_dpp(__builtin_bit_cast(int, (float)(idv)), __builtin_bit_cast(int, (float)(x)), (ctrl), (rmask), 0xF, false))
__device__ __forceinline__ float dpp_scan_add(float x) {
    x += MK_DPPF(0.f, x, 0x111, 0xF); x += MK_DPPF(0.f, x, 0x112, 0xF); x += MK_DPPF(0.f, x, 0x114, 0xF); x += MK_DPPF(0.f, x, 0x118, 0xF);
    x += MK_DPPF(0.f, x, 0x142, 0xA); x += MK_DPPF(0.f, x, 0x143, 0xC); return x; }
__device__ __forceinline__ float dpp_scan_max(float x) {
    x = fmaxf(x, MK_DPPF(-3.0e38f, x, 0x111, 0xF)); x = fmaxf(x, MK_DPPF(-3.0e38f, x, 0x112, 0xF)); x = fmaxf(x, MK_DPPF(-3.0e38f, x, 0x114, 0xF)); x = fmaxf(x, MK_DPPF(-3.0e38f, x, 0x118, 0xF));
    x = fmaxf(x, MK_DPPF(-3.0e38f, x, 0x142, 0xA)); x = fmaxf(x, MK_DPPF(-3.0e38f, x, 0x143, 0xC)); return x; }
__device__ __forceinline__ float lane63(float x) { return __builtin_bit_cast(float, __builtin_amdgcn_readlane(__builtin_bit_cast(int, x), 63)); }
__device__ __forceinline__ int shupi(int v, int d, int lane) { return shfi(v, lane >= d ? lane - d : lane); }
__device__ __forceinline__ float wave_sum(float v, int lane) {
#pragma unroll
    for (int o = 1; o < 64; o <<= 1) v += shx(v, o, lane);
    return v;
}
__device__ __forceinline__ float wave_max(float v, int lane) {
#pragma unroll
    for (int o = 1; o < 64; o <<= 1) v = fmaxf(v, shx(v, o, lane));
    return v;
}
__device__ __forceinline__ float log_sigmoid(float x) { return fminf(x, 0.f) - log1pf(__expf(-fabsf(x))); }

#define XB_TMO      128
#define XB_XCNT(j)  (256  + 64 * (j))
#define XB_XSUB(j)  (1280 + 64 * (j))
#define XB_XGEN(j)  (2304 + 64 * (j))
#define XB_TOP      3328
#define XB_TOPGEN   3392
#define XCD_BAR_WORDS 3456
#define XB_SPIN_CAP (1u << 18)
__device__ __forceinline__ unsigned xb_ld(unsigned* p)              { return __hip_atomic_load(p, __ATOMIC_RELAXED, __HIP_MEMORY_SCOPE_AGENT); }
__device__ __forceinline__ unsigned xb_add(unsigned* p, unsigned v) { return __hip_atomic_fetch_add(p, v, __ATOMIC_RELAXED, __HIP_MEMORY_SCOPE_AGENT); }
__device__ __forceinline__ unsigned xb_xcc_id() { return (unsigned)__builtin_amdgcn_s_getreg((3 << 11) | 20) & 0xFu; }
#define XB_SPIN(cond, bar) do { unsigned _sp = 0; while (cond) { __builtin_amdgcn_s_sleep(1); \
    if ((++_sp & 255u) == 0u) { if (xb_ld(&(bar)[XB_TMO])) break; if (_sp > XB_SPIN_CAP) { atomicAdd(&(bar)[XB_TMO], 1u); break; } } } } while (0)
struct XcdBarrier { unsigned* bar; unsigned x; volatile LAS unsigned* st; };
__device__ __forceinline__ XcdBarrier xcd_barrier_post(unsigned* bar, volatile LAS unsigned* st) {
    XcdBarrier b; b.bar = bar; b.x = xb_xcc_id(); b.st = st;
    if (threadIdx.x == 0) (void)xb_add(&bar[XB_XCNT(b.x)], 1u);
    return b;
}
__device__ __forceinline__ void xcd_barrier_complete(unsigned* bar, unsigned x, unsigned& nloc, unsigned& nx) {
    const unsigned G = gridDim.x * gridDim.y * gridDim.z;
    unsigned sum, cnt, mine, sp = 0u;
    for (;;) {
        sum = 0u; cnt = 0u; mine = 0u;
#pragma unroll
        for (unsigned j = 0; j < 16; ++j) { const unsigned c = xb_ld(&bar[XB_XCNT(j)]); sum += c; cnt += (c > 0u) ? 1u : 0u; mine = (j == x) ? c : mine; }
        if (sum == G) break;
        __builtin_amdgcn_s_sleep(1);
        if ((++sp & 255u) == 0u) { if (xb_ld(&bar[XB_TMO])) break; if (sp > XB_SPIN_CAP) { atomicAdd(&bar[XB_TMO], 1u); break; } }
    }
    nloc = mine > 0u ? mine : 1u; nx = cnt > 0u ? cnt : 1u;
}
__device__ __forceinline__ void xcd_barrier(const XcdBarrier& b) {
    asm volatile("s_waitcnt vmcnt(0)" ::: "memory");
    __syncthreads();
    if (threadIdx.x == 0) {
        unsigned* bar = b.bar;
        __builtin_amdgcn_s_waitcnt(0);
        unsigned nloc = b.st[0], nx = b.st[1];
        if (nloc == 0u) { xcd_barrier_complete(bar, b.x, nloc, nx); b.st[0] = nloc; b.st[1] = nx; }
        const unsigned old = xb_add(&bar[XB_XSUB(b.x)], 1u);
        const unsigned gen = old / nloc;
        if (old + 1u == (gen + 1u) * nloc) {
            __builtin_amdgcn_fence(__ATOMIC_RELEASE, "agent");
            asm volatile("s_waitcnt vmcnt(0)" ::: "memory");
            const unsigned og = xb_add(&bar[XB_TOP], 1u);
            const unsigned tg = og / nx;
            if (og + 1u == (tg + 1u) * nx) xb_add(&bar[XB_TOPGEN], 1u);
            else XB_SPIN(xb_ld(&bar[XB_TOPGEN]) == tg, bar);
            __builtin_amdgcn_fence(__ATOMIC_ACQUIRE, "agent");
            xb_add(&bar[XB_XGEN(b.x)], 1u);
            asm volatile("s_waitcnt vmcnt(0)" ::: "memory");
        } else {
            XB_SPIN(xb_ld(&bar[XB_XGEN(b.x)]) == gen, bar);
            __builtin_amdgcn_fence(__ATOMIC_ACQUIRE, "agent");
            asm volatile("s_waitcnt vmcnt(0)" ::: "memory");
        }
    }
    __syncthreads();
}

namespace pg8 {
constexpr int NA_SLOT_OFF = 131072 + 4096;
constexpr int BM = 256, BK = 64, HALF = 128, HTB = HALF * BK * 2, NXCD = 8, WGM = 8;
__device__ __forceinline__ int lds_byte(int r, int c) { const int st = (r >> 4) * 2 + (c >> 5), rr = r & 15, cc = c & 31, ob = rr * 64 + cc * 2; return st * 1024 + (ob ^ (((ob >> 9) & 1) << 5)); }
__device__ __forceinline__ void stage_rc(int b, int& R, int& C) { const int st = b / 1024, sb = b % 1024, swz = sb ^ (((sb >> 9) & 1) << 5); R = (st >> 1) * 16 + swz / 64; C = (st & 1) * 32 + (swz % 64) / 2; }
__device__ __forceinline__ int perm32(int rho) { const int n = rho >> 4, i = rho & 15; return 8 * (i >> 2) + 4 * n + (i & 3); }
typedef __bf16 bf16x2_t __attribute__((ext_vector_type(2)));
__device__ __forceinline__ unsigned cvt_pk_bf16(float lo, float hi) { const f32x2 v = {lo, hi}; return __builtin_bit_cast(unsigned, __builtin_convertvector(v, bf16x2_t)); }

struct Unit { int pm, pn; };
struct UnitM { int pm, pn, e, cnt, rb; };

struct DenseOrder {
    int nM, nN, nwg, G, c;
    __device__ void init(int M, int N, int G_, int c_) { nM = M / BM; nN = N / BM; nwg = nM * nN; G = G_; c = c_; }
    __device__ bool next(int i, Unit& u) const { return at((long)i * G + c, u); }
    __device__ bool at(long L, Unit& u) const {
        if (L < 0 || L >= nwg) return false;
        int wgid = (int)L; { const int q = nwg / NXCD, r = nwg % NXCD, xcd = wgid % NXCD, off = wgid / NXCD; wgid = (xcd < r ? xcd * (q + 1) : r * (q + 1) + (xcd - r) * q) + off; }
        const int nig = WGM * nN, gid = wgid / nig, fm = gid * WGM, gsz = (nM - fm) < WGM ? (nM - fm) : WGM;
        u.pm = fm + ((wgid % nig) % gsz); u.pn = (wgid % nig) / gsz; return true;
    }
};

#define PG8_SA(b, h) (((b) * 2 + (h)) * HTB)
#define PG8_SB(b, h) ((4 + (b) * 2 + (h)) * HTB)
#define PG8_STAGE(bufoff, gbase, v0, v1) do { \
        __builtin_amdgcn_global_load_lds((const unsigned*)((const char*)(gbase) + (v0)), (LAS unsigned*)(lds + (bufoff) + ldsw), 16, 0, 0); \
        __builtin_amdgcn_global_load_lds((const unsigned*)((const char*)(gbase) + (v1)), (LAS unsigned*)(lds + (bufoff) + ldsw + 8192), 16, 0, 0); } while (0)
#define PG8_LDA(dst, b, h) do { _Pragma("unroll") for (int m = 0; m < 4; ++m) _Pragma("unroll") for (int k = 0; k < 2; ++k) dst[m][k] = *(const LAS bf16x8*)(lds + PG8_SA(b, h) + aoff + m * 2048 + k * 1024); } while (0)
#define PG8_LDB(dst, b, h) do { _Pragma("unroll") for (int n = 0; n < 2; ++n) _Pragma("unroll") for (int k = 0; k < 2; ++k) dst[n][k] = *(const LAS bf16x8*)(lds + PG8_SB(b, h) + boff + n * 2048 + k * 1024); } while (0)
#define PG8_MMA(ai, bj, At, Bt) do { __builtin_amdgcn_s_setprio(1); _Pragma("unroll") for (int m = 0; m < 4; ++m) _Pragma("unroll") for (int n = 0; n < 2; ++n) _Pragma("unroll") for (int k = 0; k < 2; ++k) \
        acc[ai][bj][m][n] = __builtin_amdgcn_mfma_f32_16x16x32_bf16(Bt[n][k], At[m][k], acc[ai][bj][m][n], 0, 0, 0); __builtin_amdgcn_s_setprio(0); } while (0)
#define PG8_WAIT_V(n) asm volatile("s_waitcnt vmcnt(" #n ")" ::: "memory")
#define PG8_WAIT_L(n) asm volatile("s_waitcnt lgkmcnt(" #n ")" ::: "memory")
#define PG8_BAR __builtin_amdgcn_s_barrier()
#define PG8_SCHED __builtin_amdgcn_sched_barrier(0)

template <class Epi, class Prob>
__device__ __forceinline__ void gemm_phase(LAS unsigned char* lds, const Prob& P, const Epi& E, const int tid) {
    typedef typename Prob::Unit Unit;
    constexpr bool GA = Prob::GATHER;
#ifndef MK_ALIGN_EPI
#define MK_ALIGN_EPI 1
#endif
    constexpr bool ALIGN_EPI = MK_ALIGN_EPI;
    const int wid = __builtin_amdgcn_readfirstlane(tid >> 6), lane = tid & 63, wr = wid >> 2, wc = wid & 3, fr = lane & 15, fq = lane >> 4;
    const int K = P.K, nt = K / BK;
    unsigned vb0, vb1;
    unsigned va00, va01, va10, va11;
    { int R0, C0, R1, C1; stage_rc(tid * 16, R0, C0); stage_rc(tid * 16 + 8192, R1, C1);
      vb0 = (unsigned)(Epi::brow(R0) * K + C0) * 2u; vb1 = (unsigned)(Epi::brow(R1) * K + C1) * 2u; }
    const unsigned ldsw = (unsigned)wid * 1024u;
    const int aoff = lds_byte(wr * 64 + fr, fq * 8), boff = lds_byte(wc * 32 + fr, fq * 8);
    Unit cur, nxt; int ui = 0;
    if (!P.first(cur, tid)) return;
    f32x4 acc[2][2][4][2];
#pragma unroll
    for (int a = 0; a < 2; ++a)
#pragma unroll
        for (int b = 0; b < 2; ++b)
#pragma unroll
            for (int m = 0; m < 4; ++m)
#pragma unroll
                for (int n = 0; n < 2; ++n) acc[a][b][m][n] = (f32x4){0.f, 0.f, 0.f, 0.f};
    bf16x8 At[4][2], B0[2][2], B1[2][2];
    { int R0, C0, R1, C1; stage_rc(tid * 16, R0, C0); stage_rc(tid * 16 + 8192, R1, C1);
      va00 = P.a_off(cur, 0, R0, C0); va01 = P.a_off(cur, 0, R1, C1);
      if (GA) { va10 = P.a_off(cur, 1, R0, C0); va11 = P.a_off(cur, 1, R1, C1); } else { va10 = va00; va11 = va01; } }
    const char* cA0 = P.a_ptr(cur, 0); const char* cA1 = P.a_ptr(cur, 1); const char* cB0 = P.b_ptr(cur, 0); const char* cB1 = P.b_ptr(cur, 1);
    const size_t kstep = (size_t)(BK * 2);
    P.a_ready(cur, tid);
    PG8_STAGE(PG8_SB(0, 0), cB0, vb0, vb1); PG8_STAGE(PG8_SB(0, 1), cB1, vb0, vb1); PG8_STAGE(PG8_SA(0, 0), cA0, va00, va01); PG8_STAGE(PG8_SA(0, 1), cA1, va10, va11);
    if (wr == 1) PG8_BAR;
    PG8_WAIT_V(2); PG8_BAR;
    PG8_STAGE(PG8_SB(1, 0), cB0 + kstep, vb0, vb1); PG8_STAGE(PG8_SA(1, 0), cA0 + kstep, va00, va01); PG8_STAGE(PG8_SB(1, 1), cB1 + kstep, vb0, vb1);
    PG8_WAIT_V(6); PG8_BAR;
    for (;;) {
        const int req = P.request(ui + 1, tid);
        bool has_next = false;
        const char* nA0 = cA0; const char* nA1 = cA1; const char* nB0 = cB0; const char* nB1 = cB1;
        for (int t = 0; t < nt; t += 2) {
            const bool last = (t == nt - 2);
            if (t == nt - 4) P.post(ui + 1, tid, req);
            if (last) { has_next = P.fetch(ui + 1, nxt);
                if (has_next) { nA0 = P.a_ptr(nxt, 0); nA1 = P.a_ptr(nxt, 1); nB0 = P.b_ptr(nxt, 0); nB1 = P.b_ptr(nxt, 1); P.a_ready(nxt, tid);
                    if (GA) { int R0, C0, R1, C1; stage_rc(tid * 16, R0, C0); stage_rc(tid * 16 + 8192, R1, C1);
                        v4u nv; nv.x = P.a_off(nxt, 0, R0, C0); nv.y = P.a_off(nxt, 0, R1, C1); nv.z = P.a_off(nxt, 1, R0, C0); nv.w = P.a_off(nxt, 1, R1, C1);
                        *(LAS v4u*)(lds + NA_SLOT_OFF + tid * 16) = nv; } } }
            const char* a11 = cA1 + (size_t)(t + 1) * kstep;
            const char* a20 = last ? nA0 : cA0 + (size_t)(t + 2) * kstep; const char* a21 = last ? nA1 : cA1 + (size_t)(t + 2) * kstep;
            const char* b20 = last ? nB0 : cB0 + (size_t)(t + 2) * kstep; const char* b21 = last ? nB1 : cB1 + (size_t)(t + 2) * kstep;
            PG8_LDB(B0, 0, 0); PG8_LDB(B1, 0, 1); PG8_SCHED; PG8_LDA(At, 0, 0); PG8_STAGE(PG8_SA(1, 1), a11, va10, va11);
            if (GA) { if (last && has_next) { const v4u nv = *(const LAS v4u*)(lds + NA_SLOT_OFF + tid * 16); va00 = nv.x; va01 = nv.y; va10 = nv.z; va11 = nv.w; } }
            PG8_WAIT_V(8); PG8_WAIT_L(0); PG8_BAR; PG8_MMA(0, 0, At, B0); PG8_MMA(0, 1, At, B1); PG8_BAR; PG8_SCHED;
            PG8_LDA(At, 0, 1); PG8_STAGE(PG8_SB(0, 0), b20, vb0, vb1); PG8_STAGE(PG8_SB(0, 1), b21, vb0, vb1); PG8_STAGE(PG8_SA(0, 0), a20, va00, va01);
            PG8_WAIT_V(8); PG8_WAIT_L(0); PG8_BAR; PG8_MMA(1, 0, At, B0); PG8_MMA(1, 1, At, B1); PG8_BAR; PG8_SCHED;
            PG8_LDB(B0, 1, 0); PG8_LDB(B1, 1, 1); PG8_SCHED; PG8_LDA(At, 1, 0); PG8_STAGE(PG8_SA(0, 1), a21, va10, va11);
            PG8_WAIT_V(8); PG8_WAIT_L(0); PG8_BAR; PG8_MMA(0, 0, At, B0); PG8_MMA(0, 1, At, B1); PG8_BAR; PG8_SCHED;
            PG8_LDA(At, 1, 1); PG8_STAGE(PG8_SB(1, 0), b20 + kstep, vb0, vb1); PG8_STAGE(PG8_SB(1, 1), b21 + kstep, vb0, vb1); PG8_STAGE(PG8_SA(1, 0), a20 + kstep, va00, va01);
            PG8_WAIT_V(8); PG8_WAIT_L(0); PG8_BAR; PG8_MMA(1, 0, At, B0); PG8_MMA(1, 1, At, B1); PG8_BAR; PG8_SCHED;
        }
        if (ALIGN_EPI) { if (wr == 0) PG8_BAR; }
        E(acc, cur, wr, wc, fr, fq);
        P.done(cur, lane);
        if (!has_next) break;
#pragma unroll
        for (int a = 0; a < 2; ++a)
#pragma unroll
            for (int b = 0; b < 2; ++b)
#pragma unroll
                for (int m = 0; m < 4; ++m)
#pragma unroll
                    for (int n = 0; n < 2; ++n) acc[a][b][m][n] = (f32x4){0.f, 0.f, 0.f, 0.f};
        cur = nxt; cA0 = nA0; cA1 = nA1; cB0 = nB0; cB1 = nB1; ++ui;
        if (ALIGN_EPI) { if (wr == 1) PG8_BAR; }
    }
    PG8_WAIT_V(0);
    if (!ALIGN_EPI) { if (wr == 0) PG8_BAR; }
    PG8_BAR;
}
}

struct ProbDense {
    typedef pg8::Unit Unit;
    static constexpr bool GATHER = false;
    int K; const char* A; const char* Bt; pg8::DenseOrder ord; int bhalf_rows;
    __device__ __forceinline__ bool first(Unit& u, int) const { return ord.next(0, u); }
    __device__ __forceinline__ int request(int, int) const { return 0; }
    __device__ __forceinline__ void post(int, int, int) const {}
    __device__ __forceinline__ bool fetch(int i, Unit& u) const { return ord.next(i, u); }
    __device__ __forceinline__ void a_ready(const Unit&, int) const {}
    __device__ __forceinline__ void done(const Unit&, int) const {}
    __device__ __forceinline__ const char* a_ptr(const Unit& u, int h) const { return A + (size_t)(u.pm * 256 + h * 128) * K * 2; }
    __device__ __forceinline__ unsigned a_off(const Unit& u, int h, int R, int C) const { return (unsigned)(R * K + C) * 2u; }
    __device__ __forceinline__ const char* b_ptr(const Unit& u, int h) const { return Bt + ((size_t)(u.pn * 256 + h * bhalf_rows) * K) * 2; }
};
struct ProbDenseDyn {
    typedef pg8::Unit Unit;
    static constexpr bool GATHER = false;
    int K; const char* A; const char* Bt; pg8::DenseOrder ord; int bhalf_rows; unsigned* head; LAS int* slot; int xlab;
    __device__ __forceinline__ int pull() const {
        int res = -1;
#pragma unroll 1
        for (int k = 0; k < 8; ++k) { const int x = (xlab + k) & 7; const int q = __builtin_amdgcn_readfirstlane((int)__hip_atomic_fetch_add(head + 64 * x, 1u, RLX_AGENT));
            if (8 * q + x < ord.nwg) { res = 8 * q + x; break; } }
        return res; }
    __device__ __forceinline__ bool first(Unit& u, int tid) const { if (tid == 0) slot[0] = pull(); __syncthreads(); return ord.at(__builtin_amdgcn_readfirstlane(slot[0]), u); }
    __device__ __forceinline__ int request(int, int tid) const { int r = 0; if (tid == 0) r = pull(); return r; }
    __device__ __forceinline__ void post(int i, int tid, int r) const { if (tid == 0) slot[i & 1] = r; }
    __device__ __forceinline__ bool fetch(int i, Unit& u) const { return ord.at(__builtin_amdgcn_readfirstlane(slot[i & 1]), u); }
    __device__ __forceinline__ void a_ready(const Unit&, int) const {}
    __device__ __forceinline__ void done(const Unit&, int) const {}
    __device__ __forceinline__ const char* a_ptr(const Unit& u, int h) const { return A + (size_t)(u.pm * 256 + h * 128) * K * 2; }
    __device__ __forceinline__ unsigned a_off(const Unit& u, int h, int R, int C) const { return (unsigned)(R * K + C) * 2u; }
    __device__ __forceinline__ const char* b_ptr(const Unit& u, int h) const { return Bt + ((size_t)(u.pn * 256 + h * bhalf_rows) * K) * 2; }
};
constexpr int MOE_TAB_OFF = LDSCTL_OFF + 1024;
__device__ __forceinline__ void moe_tables(LAS unsigned char* lds, const unsigned* cnt, int tid) {
    LAS int* tab = (LAS int*)(lds + MOE_TAB_OFF);
    if (tid < 64) { const int n = (tid < NE) ? (int)__hip_atomic_load(cnt + 64 * (tid & 31), RLX_AGENT) : 0; int x = (n + 255) >> 8;
#pragma unroll
        for (int o = 1; o < 64; o <<= 1) { const int y = shupi(x, o, tid); if (tid >= o) x += y; }
        if (tid < NE) { tab[tid + 1] = x; tab[40 + tid] = n; } if (tid == 0) tab[0] = 0; }
    __syncthreads();
}
constexpr int MOE_SLOT_OFF = MOE_TAB_OFF + 512;
struct MoeTiles {
    LAS const int* tab; unsigned* head; unsigned* done; LAS int* slot; int lane;
    __device__ __forceinline__ bool unit(int L, pg8::UnitM& u) const {
        const int tile = L >> 2;
        const int tpl = tab[lane & 31];
        const unsigned long long m = __ballot(lane < 32 && tpl <= tile);
        const int e = __builtin_amdgcn_readfirstlane(__popcll(m) - 1);
        const int total = __builtin_amdgcn_readfirstlane(tab[32]);
        if (tile >= total) return false;
        const int tp = __builtin_amdgcn_readfirstlane(tab[e]), n = __builtin_amdgcn_readfirstlane(tab[40 + e]);
        u.e = e; u.rb = (tile - tp) * 256; u.cnt = n - u.rb; u.pm = tile; u.pn = L & 3; return true;
    }
    __device__ __forceinline__ bool first(pg8::UnitM& u, int tid) const {
        if (tid == 0) slot[0] = (int)__hip_atomic_fetch_add(head, 1u, RLX_AGENT);
        __syncthreads();
        return unit(__builtin_amdgcn_readfirstlane(slot[0]), u); }
    __device__ __forceinline__ int request(int i, int tid) const { int r = 0; if (tid == 0) r = (int)__hip_atomic_fetch_add(head, 1u, RLX_AGENT); return r; }
    __device__ __forceinline__ void post(int i, int tid, int r) const { if (tid == 0) slot[i & 1] = r; }
    __device__ __forceinline__ bool fetch(int i, pg8::UnitM& u) const { return unit(__builtin_amdgcn_readfirstlane(slot[i & 1]), u); }
    __device__ __forceinline__ void publish(const pg8::UnitM& u, int lane_) const {
        asm volatile("s_waitcnt vmcnt(0)" ::: "memory");
        if (lane_ == 0) (void)__hip_atomic_fetch_add(done + 64 * u.pm, 1u, RLX_AGENT); }
    __device__ __forceinline__ void wait_tile(const pg8::UnitM& u, int tid) const {
        if (tid < 64) { unsigned polls = 0;
            while ((unsigned)__builtin_amdgcn_readfirstlane((int)__hip_atomic_load(done + 64 * u.pm, RLX_AGENT)) < 32u) { __builtin_amdgcn_s_sleep(2); if (++polls > (1u << 21)) break; }
            __builtin_amdgcn_fence(__ATOMIC_ACQUIRE, "agent");
            asm volatile("s_waitcnt vmcnt(0)" ::: "memory"); }
        asm volatile("" ::: "memory"); __builtin_amdgcn_s_barrier(); asm volatile("" ::: "memory"); }
};
struct ProbMoe1 {
    typedef pg8::UnitM Unit;
    static constexpr bool GATHER = true;
    int K; const char* A; const char* Wg; const char* Wu; const int* list; MoeTiles mt;
    __device__ __forceinline__ bool first(Unit& u, int tid) const { return mt.first(u, tid); }
    __device__ __forceinline__ int request(int i, int tid) const { return mt.request(i, tid); }
    __device__ __forceinline__ void post(int i, int tid, int r) const { mt.post(i, tid, r); }
    __device__ __forceinline__ bool fetch(int i, Unit& u) const { return mt.fetch(i, u); }
    __device__ __forceinline__ void a_ready(const Unit&, int) const {}
    __device__ __forceinline__ void done(const Unit& u, int lane_) const { mt.publish(u, lane_); }
    __device__ __forceinline__ const char* a_ptr(const Unit& u, int h) const { return A; }
    __device__ __forceinline__ unsigned a_off(const Unit& u, int h, int R, int C) const {
        const int r = h * 128 + R; int tok = T;
        if (r < u.cnt) tok = list[u.e * 16384 + u.rb + r];
        return (unsigned)(tok * 1024 + C) * 2u; }
    __device__ __forceinline__ const char* b_ptr(const Unit& u, int h) const { return (h ? Wu : Wg) + ((size_t)u.e * 512 * 1024 + (size_t)u.pn * 128 * 1024) * 2; }
};
struct ProbMoe2 {
    typedef pg8::UnitM Unit;
    static constexpr bool GATHER = false;
    int K; const char* A; const char* Wd; MoeTiles mt;
    __device__ __forceinline__ bool first(Unit& u, int tid) const { return mt.first(u, tid); }
    __device__ __forceinline__ int request(int i, int tid) const { return mt.request(i, tid); }
    __device__ __forceinline__ void post(int i, int tid, int r) const { mt.post(i, tid, r); }
    __device__ __forceinline__ bool fetch(int i, Unit& u) const { return mt.fetch(i, u); }
    __device__ __forceinline__ void a_ready(const Unit& u, int tid) const { mt.wait_tile(u, tid); }
    __device__ __forceinline__ void done(const Unit&, int) const {}
    __device__ __forceinline__ const char* a_ptr(const Unit& u, int h) const { return A + (size_t)(u.pm * 256 + h * 128) * 512 * 2; }
    __device__ __forceinline__ unsigned a_off(const Unit& u, int h, int R, int C) const { return (unsigned)(R * 512 + C) * 2u; }
    __device__ __forceinline__ const char* b_ptr(const Unit& u, int h) const { return Wd + ((size_t)u.e * 1024 * 512 + (size_t)(u.pn * 256 + h * 32) * 512) * 2; }
};

struct EpiBf16Plain {
    bf16* O; int ldc; int sc_lo, sc_hi; float scale; bf16* O2; int ldc2, split_pn;
    static __device__ __forceinline__ int brow(int rho) { return 64 * (rho >> 5) + pg8::perm32(rho & 31); }
    template <class UnitT> __device__ __forceinline__ void operator()(const f32x4 (&acc)[2][2][4][2], const UnitT& u, int wr, int wc, int fr, int fq) const {
        const bool second = u.pn >= split_pn; bf16* const Ob = second ? O2 : O; const int ld = second ? ldc2 : ldc;
        const int row0 = u.pm * 256 + wr * 64 + fr, col0 = (second ? u.pn - split_pn : u.pn) * 256 + wc * 64 + 8 * fq;
        const float sc = (u.pn >= sc_lo && u.pn < sc_hi) ? scale : 1.f;
#pragma unroll
        for (int ai = 0; ai < 2; ++ai)
#pragma unroll
            for (int m = 0; m < 4; ++m) { bf16* rowp = Ob + (size_t)(row0 + ai * 128 + m * 16) * ld + col0;
#pragma unroll
                for (int bj = 0; bj < 2; ++bj) { const f32x4 v0 = acc[ai][bj][m][0] * sc, v1 = acc[ai][bj][m][1] * sc;
                    v4u w; w.x = pg8::cvt_pk_bf16(v0[0], v0[1]); w.y = pg8::cvt_pk_bf16(v0[2], v0[3]); w.z = pg8::cvt_pk_bf16(v1[0], v1[1]); w.w = pg8::cvt_pk_bf16(v1[2], v1[3]);
                    if (Ob) *(v4u*)(rowp + bj * 32) = w; else asm volatile("" :: "v"(w)); } }
    }
};
struct EpiEvIn {
    bf16* O; const float* qg; const float* kg;
    static __device__ __forceinline__ int brow(int rho) { return 64 * (rho >> 5) + pg8::perm32(rho & 31); }
    __device__ __forceinline__ void operator()(const f32x4 (&acc)[2][2][4][2], const pg8::Unit& u, int wr, int wc, int fr, int fq) const {
        const int row0 = u.pm * 256 + wr * 64 + fr, col0 = u.pn * 256 + wc * 64 + 8 * fq;
        const bool nrm = u.pn < 4; const float* gp = (u.pn < 2) ? qg : kg; const float post = (u.pn < 2) ? 0.125f : 1.f;
        f32x4 g[2][2];
#pragma unroll
        for (int bj = 0; bj < 2; ++bj)
#pragma unroll
            for (int n = 0; n < 2; ++n) g[bj][n] = nrm ? *(const f32x4*)(gp + 32 * bj + 8 * fq + 4 * n) * post : (f32x4){1.f, 1.f, 1.f, 1.f};
#pragma unroll
        for (int ai = 0; ai < 2; ++ai)
#pragma unroll
            for (int m = 0; m < 4; ++m) {
                float r = 1.f;
                if (nrm) { float ss = 0.f;
#pragma unroll
                    for (int bj = 0; bj < 2; ++bj)
#pragma unroll
                        for (int n = 0; n < 2; ++n) { const f32x4 x = acc[ai][bj][m][n]; ss += (x[0] * x[0] + x[1] * x[1]) + (x[2] * x[2] + x[3] * x[3]); }
                    ss += shx(ss, 16, fq * 16 + fr); ss += shx(ss, 32, fq * 16 + fr);
                    r = rsqrtf(ss * (1.f / 64.f) + RMS_EPS); }
                bf16* rowp = O + (size_t)(row0 + ai * 128 + m * 16) * PU + col0;
#pragma unroll
                for (int bj = 0; bj < 2; ++bj) { const f32x4 v0 = acc[ai][bj][m][0] * r * g[bj][0], v1 = acc[ai][bj][m][1] * r * g[bj][1];
                    v4u w; w.x = pg8::cvt_pk_bf16(v0[0], v0[1]); w.y = pg8::cvt_pk_bf16(v0[2], v0[3]); w.z = pg8::cvt_pk_bf16(v1[0], v1[1]); w.w = pg8::cvt_pk_bf16(v1[2], v1[3]);
                    *(v4u*)(rowp + bj * 32) = w; } }
    }
};
struct EpiResid {
    const float* resid; float* out;
    static __device__ __forceinline__ int brow(int rho) { return rho; }
    __device__ __forceinline__ void operator()(const f32x4 (&acc)[2][2][4][2], const pg8::Unit& u, int wr, int wc, int fr, int fq) const {
        const int row0 = u.pm * 256 + wr * 64 + fr, col0 = u.pn * 256 + wc * 32 + 4 * fq;
#pragma unroll
        for (int ai = 0; ai < 2; ++ai)
#pragma unroll
            for (int m = 0; m < 4; ++m) { const size_t off = (size_t)(row0 + ai * 128 + m * 16) * D + col0;
#pragma unroll
                for (int bj = 0; bj < 2; ++bj)
#pragma unroll
                    for (int n = 0; n < 2; ++n) { const f32x4 b = *(const f32x4*)(resid + off + bj * 128 + n * 16); *(f32x4*)(out + off + bj * 128 + n * 16) = b + acc[ai][bj][m][n]; } }
    }
};
struct EpiMoe1 {
    bf16* H;
    static __device__ __forceinline__ int brow(int rho) { return (rho & ~31) + pg8::perm32(rho & 31); }
    __device__ __forceinline__ void operator()(const f32x4 (&acc)[2][2][4][2], const pg8::UnitM& u, int wr, int wc, int fr, int fq) const {
        const int row0 = u.pm * 256 + wr * 64 + fr, col0 = u.pn * 128 + wc * 32 + 8 * fq;
#pragma unroll
        for (int ai = 0; ai < 2; ++ai)
#pragma unroll
            for (int m = 0; m < 4; ++m) { bf16* rowp = H + (size_t)(row0 + ai * 128 + m * 16) * FF + col0; float o[8];
#pragma unroll
                for (int n = 0; n < 2; ++n)
#pragma unroll
                    for (int i = 0; i < 4; ++i) { const float g = acc[ai][0][m][n][i], up = acc[ai][1][m][n][i]; o[4 * n + i] = g / (1.f + __expf(-g)) * up; }
                v4u w; w.x = pg8::cvt_pk_bf16(o[0], o[1]); w.y = pg8::cvt_pk_bf16(o[2], o[3]); w.z = pg8::cvt_pk_bf16(o[4], o[5]); w.w = pg8::cvt_pk_bf16(o[6], o[7]);
                asm volatile("global_store_dwordx4 %0, %1, off sc1\n\ts_nop 1" :: "v"(rowp), "v"(w) : "memory"); }
    }
};

struct Frame {
    LAS unsigned char* lds; volatile LAS unsigned* MISC;
    int tid, lane, wave, vcu, G, bx;
};

typedef short s16x4 __attribute__((ext_vector_type(4)));
__device__ __forceinline__ bf16x8 lds_tr_frag(const LAS unsigned char* a, int row4_bytes) {
    const s16x4 lo = __builtin_amdgcn_ds_read_tr16_b64_v4i16((LAS s16x4*)a), hi = __builtin_amdgcn_ds_read_tr16_b64_v4i16((LAS s16x4*)(a + row4_bytes));
    return (bf16x8){lo[0], lo[1], lo[2], lo[3], hi[0], hi[1], hi[2], hi[3]};
}
__device__ __forceinline__ void convert_weights(Frame& F, const float* W, int Kd, int Nd, int ldw, size_t src_stride, bf16* WT, size_t dst_stride, int nmat, int gw_ = -1, int ngw_ = 0) {
    constexpr int TP = 144;
    LAS unsigned char* tl = F.lds + F.wave * 9216;
    const int gw = gw_ >= 0 ? gw_ : F.vcu * 8 + F.wave, NGW = gw_ >= 0 ? ngw_ : F.G * 8, lane = F.lane, l16 = lane & 15, lq = lane >> 4;
    const int nblk = Nd / 64, per = (Kd / 64) * nblk, total = per * nmat;
    f32x4 nv[16];
    if (gw < total) { const int mtx = gw / per, r = gw % per, kb = r / nblk, nb = r % nblk;
        const float* src = W + (size_t)mtx * src_stride + (size_t)(64 * kb + lq) * ldw + 64 * nb + 4 * l16;
#pragma unroll
        for (int i = 0; i < 16; ++i) nv[i] = __builtin_nontemporal_load((const GAS f32x4*)(src + (size_t)(4 * i) * ldw)); }
    for (int it = gw; it < total; it += NGW) { const int mtx = it / per, r = it % per, kb = r / nblk, nb = r % nblk;
        f32x4 v[16];
#pragma unroll
        for (int i = 0; i < 16; ++i) v[i] = nv[i];
        if (it + NGW < total) { const int it2 = it + NGW, mtx2 = it2 / per, r2 = it2 % per, kb2 = r2 / nblk, nb2 = r2 % nblk;
            const float* src = W + (size_t)mtx2 * src_stride + (size_t)(64 * kb2 + lq) * ldw + 64 * nb2 + 4 * l16;
#pragma unroll
            for (int i = 0; i < 16; ++i) nv[i] = __builtin_nontemporal_load((const GAS f32x4*)(src + (size_t)(4 * i) * ldw)); }
#pragma unroll
        for (int i = 0; i < 16; ++i) { const int k = 4 * i + lq; v2u w; w.x = pg8::cvt_pk_bf16(v[i][0], v[i][1]); w.y = pg8::cvt_pk_bf16(v[i][2], v[i][3]); *(LAS v2u*)(tl + k * TP + l16 * 8) = w; }
        asm volatile("s_waitcnt lgkmcnt(0)" ::: "memory");
        bf16* dst = WT + (size_t)mtx * dst_stride + (size_t)(64 * nb) * Kd + 64 * kb;
#pragma unroll
        for (int m4 = 0; m4 < 4; ++m4) { const int n0 = 16 * m4;
            const v4u X = __builtin_bit_cast(v4u, lds_tr_frag(tl + (8 * lq + (l16 >> 2)) * TP + (n0 + 4 * (l16 & 3)) * 2, 4 * TP));
            const v4u Y = __builtin_bit_cast(v4u, lds_tr_frag(tl + (32 + 8 * lq + (l16 >> 2)) * TP + (n0 + 4 * (l16 & 3)) * 2, 4 * TP));
            v4u Xr, Yr;
            Xr.x = (unsigned)__builtin_amdgcn_update_dpp(0, (int)X.x, 0x128, 0xF, 0xF, false); Xr.y = (unsigned)__builtin_amdgcn_update_dpp(0, (int)X.y, 0x128, 0xF, 0xF, false);
            Xr.z = (unsigned)__builtin_amdgcn_update_dpp(0, (int)X.z, 0x128, 0xF, 0xF, false); Xr.w = (unsigned)__builtin_amdgcn_update_dpp(0, (int)X.w, 0x128, 0xF, 0xF, false);
            Yr.x = (unsigned)__builtin_amdgcn_update_dpp(0, (int)Y.x, 0x128, 0xF, 0xF, false); Yr.y = (unsigned)__builtin_amdgcn_update_dpp(0, (int)Y.y, 0x128, 0xF, 0xF, false);
            Yr.z = (unsigned)__builtin_amdgcn_update_dpp(0, (int)Y.z, 0x128, 0xF, 0xF, false); Yr.w = (unsigned)__builtin_amdgcn_update_dpp(0, (int)Y.w, 0x128, 0xF, 0xF, false);
            const bool lo = l16 < 8; const int kb8 = 8 * (lq + 4 * (l16 >> 3));
            v4u A, B; A.x = lo ? X.x : Yr.x; A.y = lo ? X.y : Yr.y; A.z = lo ? X.z : Yr.z; A.w = lo ? X.w : Yr.w;
            B.x = lo ? Xr.x : Y.x; B.y = lo ? Xr.y : Y.y; B.z = lo ? Xr.z : Y.z; B.w = lo ? Xr.w : Y.w;
            *(GAS v4u*)(dst + (size_t)(n0 + (l16 & 7)) * Kd + kb8) = A;
            *(GAS v4u*)(dst + (size_t)(n0 + 8 + (l16 & 7)) * Kd + kb8) = B; }
        asm volatile("s_waitcnt lgkmcnt(0)" ::: "memory");
    }
}
struct ConvSeg { const float* W; bf16* WT; int Kd, Nd, ldw, nmat; size_t sstr, dstr;
    __device__ __forceinline__ int total() const { return (Kd / 64) * (Nd / 64) * nmat; } };
struct ConvItem { const float* src; bf16* dst; int ldw, Kd; };
template <int NS> __device__ __forceinline__ ConvItem conv_locate(const ConvSeg (&sg)[NS], int idx) {
    ConvItem o; o.src = sg[0].W; o.dst = sg[0].WT; o.ldw = sg[0].ldw; o.Kd = sg[0].Kd; int r = idx; bool found = false;
#pragma unroll
    for (int q = 0; q < NS; ++q) { const int tot = sg[q].total();
        if (!found && r < tot) { const int nblk = sg[q].Nd / 64, per = (sg[q].Kd / 64) * nblk, mtx = r / per, rr = r % per, kb = rr / nblk, nb = rr % nblk;
            o.src = sg[q].W + (size_t)mtx * sg[q].sstr + (size_t)(64 * kb) * sg[q].ldw + 64 * nb; o.dst = sg[q].WT + (size_t)mtx * sg[q].dstr + (size_t)(64 * nb) * sg[q].Kd + 64 * kb;
            o.ldw = sg[q].ldw; o.Kd = sg[q].Kd; found = true; }
        if (!found) r -= tot; }
    return o;
}
template <int NS> __device__ __forceinline__ void convert_multi(Frame& F, const ConvSeg (&sg)[NS], int gw, int NGW) {
    constexpr int TP = 144;
    LAS unsigned char* tl = F.lds + F.wave * 9216;
    const int lane = F.lane, l16 = lane & 15, lq = lane >> 4;
    int total = 0;
#pragma unroll
    for (int q = 0; q < NS; ++q) total += sg[q].total();
    f32x4 nv[16]; ConvItem cur = conv_locate<NS>(sg, gw < total ? gw : 0);
    if (gw < total) { const float* src = cur.src + (size_t)lq * cur.ldw + 4 * l16;
#pragma unroll
        for (int i = 0; i < 16; ++i) nv[i] = __builtin_nontemporal_load((const GAS f32x4*)(src + (size_t)(4 * i) * cur.ldw)); }
    for (int it = gw; it < total; it += NGW) {
        f32x4 v[16];
#pragma unroll
        for (int i = 0; i < 16; ++i) v[i] = nv[i];
        const bool more = it + NGW < total; const ConvItem nxt = conv_locate<NS>(sg, more ? it + NGW : 0);
        if (more) { const float* src = nxt.src + (size_t)lq * nxt.ldw + 4 * l16;
#pragma unroll
            for (int i = 0; i < 16; ++i) nv[i] = __builtin_nontemporal_load((const GAS f32x4*)(src + (size_t)(4 * i) * nxt.ldw)); }
#pragma unroll
        for (int i = 0; i < 16; ++i) { const int k = 4 * i + lq; v2u w; w.x = pg8::cvt_pk_bf16(v[i][0], v[i][1]); w.y = pg8::cvt_pk_bf16(v[i][2], v[i][3]); *(LAS v2u*)(tl + k * TP + l16 * 8) = w; }
        asm volatile("s_waitcnt lgkmcnt(0)" ::: "memory");
        bf16* dst = cur.dst; const int Kd = cur.Kd;
#pragma unroll
        for (int m4 = 0; m4 < 4; ++m4) { const int n0 = 16 * m4;
            const v4u X = __builtin_bit_cast(v4u, lds_tr_frag(tl + (8 * lq + (l16 >> 2)) * TP + (n0 + 4 * (l16 & 3)) * 2, 4 * TP));
            const v4u Y = __builtin_bit_cast(v4u, lds_tr_frag(tl + (32 + 8 * lq + (l16 >> 2)) * TP + (n0 + 4 * (l16 & 3)) * 2, 4 * TP));
            v4u Xr, Yr;
            Xr.x = (unsigned)__builtin_amdgcn_update_dpp(0, (int)X.x, 0x128, 0xF, 0xF, false); Xr.y = (unsigned)__builtin_amdgcn_update_dpp(0, (int)X.y, 0x128, 0xF, 0xF, false);
            Xr.z = (unsigned)__builtin_amdgcn_update_dpp(0, (int)X.z, 0x128, 0xF, 0xF, false); Xr.w = (unsigned)__builtin_amdgcn_update_dpp(0, (int)X.w, 0x128, 0xF, 0xF, false);
            Yr.x = (unsigned)__builtin_amdgcn_update_dpp(0, (int)Y.x, 0x128, 0xF, 0xF, false); Yr.y = (unsigned)__builtin_amdgcn_update_dpp(0, (int)Y.y, 0x128, 0xF, 0xF, false);
            Yr.z = (unsigned)__builtin_amdgcn_update_dpp(0, (int)Y.z, 0x128, 0xF, 0xF, false); Yr.w = (unsigned)__builtin_amdgcn_update_dpp(0, (int)Y.w, 0x128, 0xF, 0xF, false);
            const bool lo = l16 < 8; const int kb8 = 8 * (lq + 4 * (l16 >> 3));
            v4u A, B; A.x = lo ? X.x : Yr.x; A.y = lo ? X.y : Yr.y; A.z = lo ? X.z : Yr.z; A.w = lo ? X.w : Yr.w;
            B.x = lo ? Xr.x : Y.x; B.y = lo ? Xr.y : Y.y; B.z = lo ? Xr.z : Y.z; B.w = lo ? Xr.w : Y.w;
            *(GAS v4u*)(dst + (size_t)(n0 + (l16 & 7)) * Kd + kb8) = A;
            *(GAS v4u*)(dst + (size_t)(n0 + 8 + (l16 & 7)) * Kd + kb8) = B; }
        asm volatile("s_waitcnt lgkmcnt(0)" ::: "memory");
        cur = nxt;
    }
}
__device__ __forceinline__ void rms_rows2_to_bf16(int lane, const float* xa, const float* xb, const float* gain, bf16* oa, bf16* ob) {
    const GAS f32x4* ra = (const GAS f32x4*)xa + lane; const GAS f32x4* rb = (const GAS f32x4*)xb + lane; const GAS f32x4* gr = (const GAS f32x4*)gain + lane;
    f32x4 va[4], vb[4]; float sa = 0.f, sb = 0.f;
#pragma unroll
    for (int j = 0; j < 4; ++j) { va[j] = __builtin_nontemporal_load(ra + 64 * j); vb[j] = __builtin_nontemporal_load(rb + 64 * j); }
#pragma unroll
    for (int j = 0; j < 4; ++j) { sa += (va[j].x * va[j].x + va[j].y * va[j].y) + (va[j].z * va[j].z + va[j].w * va[j].w); sb += (vb[j].x * vb[j].x + vb[j].y * vb[j].y) + (vb[j].z * vb[j].z + vb[j].w * vb[j].w); }
    const float r0 = rsqrtf(wave_sum(sa, lane) * (1.f / D) + RMS_EPS), r1 = rsqrtf(wave_sum(sb, lane) * (1.f / D) + RMS_EPS);
    GAS v2u* pa = (GAS v2u*)oa + lane; GAS v2u* pb = (GAS v2u*)ob + lane;
#pragma unroll
    for (int j = 0; j < 4; ++j) { const f32x4 g = gr[64 * j];
        v2u w; w.x = pg8::cvt_pk_bf16(va[j].x * r0 * g.x, va[j].y * r0 * g.y); w.y = pg8::cvt_pk_bf16(va[j].z * r0 * g.z, va[j].w * r0 * g.w); pa[64 * j] = w;
        v2u u; u.x = pg8::cvt_pk_bf16(vb[j].x * r1 * g.x, vb[j].y * r1 * g.y); u.y = pg8::cvt_pk_bf16(vb[j].z * r1 * g.z, vb[j].w * r1 * g.w); pb[64 * j] = u; }
}

struct Args { const float* in[20]; float* out; unsigned char* ws; int ph_lo, ph_hi; };

__device__ __forceinline__ void final_combine(Frame& F, const bf16* X1, const bf16* Y, const int* eid, const float* gate, const int* rel, float* out) {
    const int gw = F.vcu * 8 + F.wave, NGW = F.G * 8, lane = F.lane;
    LAS const int* tab = (LAS const int*)(F.lds + MOE_TAB_OFF);
    for (int tb = gw; tb < T; tb += 16 * NGW) {
        const int tk = tb + (lane & 15) * NGW; const bool ok = tk < T; const int tq = ok ? tk : tb;
        const int s0 = 256 * tab[eid[2 * tq]] + rel[2 * tq], s1 = 256 * tab[eid[2 * tq + 1]] + rel[2 * tq + 1]; const float g0 = gate[2 * tq], g1 = gate[2 * tq + 1];
        for (int k = 0; k < 16; k += 2) { const int ta = tb + k * NGW, tc = ta + NGW; if (ta >= T) break; const bool two = tc < T; const int tcq = two ? tc : ta;
            const int a0 = shfi(s0, k), a1 = shfi(s1, k), c0 = shfi(s0, two ? k + 1 : k), c1 = shfi(s1, two ? k + 1 : k);
            const float ga0 = shf(g0, k), ga1 = shf(g1, k), gc0 = shf(g0, two ? k + 1 : k), gc1 = shf(g1, two ? k + 1 : k);
            v2u xa_[4], xc_[4]; f32x4 va[4], vc[4]; v2u ya0[4], ya1[4], yc0[4], yc1[4];
#pragma unroll
            for (int j = 0; j < 4; ++j) { xa_[j] = __builtin_nontemporal_load(((const GAS v2u*)(X1 + (size_t)ta * D) + lane + 64 * j)); xc_[j] = __builtin_nontemporal_load(((const GAS v2u*)(X1 + (size_t)tcq * D) + lane + 64 * j));
                ya0[j] = __builtin_nontemporal_load(((const GAS v2u*)(Y + (size_t)a0 * D) + lane + 64 * j)); ya1[j] = __builtin_nontemporal_load(((const GAS v2u*)(Y + (size_t)a1 * D) + lane + 64 * j));
                yc0[j] = __builtin_nontemporal_load(((const GAS v2u*)(Y + (size_t)c0 * D) + lane + 64 * j)); yc1[j] = __builtin_nontemporal_load(((const GAS v2u*)(Y + (size_t)c1 * D) + lane + 64 * j)); }
#pragma unroll
            for (int j = 0; j < 4; ++j) { va[j] = (f32x4){bflo(xa_[j].x), bfhi(xa_[j].x), bflo(xa_[j].y), bfhi(xa_[j].y)}; vc[j] = (f32x4){bflo(xc_[j].x), bfhi(xc_[j].x), bflo(xc_[j].y), bfhi(xc_[j].y)}; }
#pragma unroll
            for (int j = 0; j < 4; ++j) { f32x4 v = va[j];
                v.x += ga0 * bflo(ya0[j].x) + ga1 * bflo(ya1[j].x); v.y += ga0 * bfhi(ya0[j].x) + ga1 * bfhi(ya1[j].x); v.z += ga0 * bflo(ya0[j].y) + ga1 * bflo(ya1[j].y); v.w += ga0 * bfhi(ya0[j].y) + ga1 * bfhi(ya1[j].y);
                *((GAS f32x4*)(out + (size_t)ta * D) + lane + 64 * j) = v; }
            if (two) {
#pragma unroll
                for (int j = 0; j < 4; ++j) { f32x4 v = vc[j];
                    v.x += gc0 * bflo(yc0[j].x) + gc1 * bflo(yc1[j].x); v.y += gc0 * bfhi(yc0[j].x) + gc1 * bfhi(yc1[j].x); v.z += gc0 * bflo(yc0[j].y) + gc1 * bflo(yc1[j].y); v.w += gc0 * bfhi(yc0[j].y) + gc1 * bfhi(yc1[j].y);
                    *((GAS f32x4*)(out + (size_t)tc * D) + lane + 64 * j) = v; } }
        }
    }
}

constexpr int ML_L = 128, ML_NC = SEQ / ML_L, ML_P = ML_L * 2 + 16;
__device__ __forceinline__ void m2_phase(Frame& F, const bf16* __restrict__ DC, bf16* __restrict__ CP, const float* __restrict__ DN, float* __restrict__ NP, const float* __restrict__ SCg, const float* __restrict__ SCm, float* __restrict__ SCp) {
    const int gt = F.vcu * 512 + F.tid, NT = F.G * 512;
    for (int i = gt; i < 64 * 2048; i += NT) {
        const int bhd = __builtin_amdgcn_readfirstlane(i >> 11), e4 = i & 2047;
        const bool nw = __builtin_amdgcn_readfirstlane(e4) < 64;
        const float gv = SCg[bhd * ML_NC + (F.lane & (ML_NC - 1))], mv = SCm[bhd * ML_NC + (F.lane & (ML_NC - 1))];
        float C0 = 0.f, C1 = 0.f, C2 = 0.f, C3 = 0.f, m = 0.f, n = 0.f;
#pragma unroll 1
        for (int c0 = 0; c0 < ML_NC; c0 += 16) { v2u dv[16]; float dn[16];
#pragma unroll
            for (int q = 0; q < 16; ++q) dv[q] = __builtin_nontemporal_load((const GAS v2u*)((const GAS char*)DC + (size_t)(bhd * ML_NC + c0 + q) * 16384 + (unsigned)(e4 * 8)));
            if (nw) {
#pragma unroll
                for (int q = 0; q < 16; ++q) dn[q] = *(const GAS float*)(DN + (size_t)(bhd * ML_NC + c0 + q) * 64 + e4); }
            else {
#pragma unroll
                for (int q = 0; q < 16; ++q) dn[q] = 0.f; }
#pragma unroll
            for (int q = 0; q < 16; ++q) { const int cd = bhd * ML_NC + c0 + q;
                const float g = __builtin_bit_cast(float, __builtin_amdgcn_readlane(__builtin_bit_cast(int, gv), c0 + q)), ml = __builtin_bit_cast(float, __builtin_amdgcn_readlane(__builtin_bit_cast(int, mv), c0 + q));
                const float mn = fmaxf(g + m, ml), a = __expf(g + m - mn), cc = __expf(ml - mn);
                v2u o; o.x = pg8::cvt_pk_bf16(C0, C1); o.y = pg8::cvt_pk_bf16(C2, C3); *(GAS v2u*)((GAS char*)CP + (size_t)cd * 16384 + (unsigned)(e4 * 8)) = o;
                if (nw) { *(GAS float*)(NP + (size_t)cd * 64 + e4) = n; if (e4 == 0) *(GAS float*)(SCp + cd) = m; }
                C0 = a * C0 + cc * bflo(dv[q].x); C1 = a * C1 + cc * bfhi(dv[q].x); C2 = a * C2 + cc * bflo(dv[q].y); C3 = a * C3 + cc * bfhi(dv[q].y);
                n = a * n + cc * dn[q]; m = mn; } }
    }
}

#define MFMA16(a, b, c) __builtin_amdgcn_mfma_f32_16x16x32_bf16((a), (b), (c), 0, 0, 0)
__device__ __forceinline__ bf16x8 pack8(const f32x4 lo, const f32x4 hi) {
    v4u w; w.x = pg8::cvt_pk_bf16(lo[0], lo[1]); w.y = pg8::cvt_pk_bf16(lo[2], lo[3]); w.z = pg8::cvt_pk_bf16(hi[0], hi[1]); w.w = pg8::cvt_pk_bf16(hi[2], hi[3]);
    return __builtin_bit_cast(bf16x8, w);
}
__device__ __forceinline__ bf16x8 scale8(const bf16x8 x, const float s) {
    const v4u u = __builtin_bit_cast(v4u, x); v4u w;
    w.x = pg8::cvt_pk_bf16(bflo(u.x) * s, bfhi(u.x) * s); w.y = pg8::cvt_pk_bf16(bflo(u.y) * s, bfhi(u.y) * s);
    w.z = pg8::cvt_pk_bf16(bflo(u.z) * s, bfhi(u.z) * s); w.w = pg8::cvt_pk_bf16(bflo(u.w) * s, bfhi(u.w) * s);
    return __builtin_bit_cast(bf16x8, w);
}
constexpr int ML_RS = 144;
template <int P> __device__ __forceinline__ void vT_put(LAS unsigned char* vT, const v4u x, int p) {
    const int row = p >> 4, pc = p & 15; LAS unsigned short* d = (LAS unsigned short*)(vT + (pc * 8) * P + row * 2);
    d[0 * (P / 2)] = (unsigned short)(x.x & 0xffff); d[1 * (P / 2)] = (unsigned short)(x.x >> 16);
    d[2 * (P / 2)] = (unsigned short)(x.y & 0xffff); d[3 * (P / 2)] = (unsigned short)(x.y >> 16);
    d[4 * (P / 2)] = (unsigned short)(x.z & 0xffff); d[5 * (P / 2)] = (unsigned short)(x.z >> 16);
    d[6 * (P / 2)] = (unsigned short)(x.w & 0xffff); d[7 * (P / 2)] = (unsigned short)(x.w >> 16);
}
__device__ __forceinline__ void ml_cumsum2(float f0, float f1, int lane, float& b0, float& b1) {
    const float s = dpp_scan_add(f0 + f1);
    const float ex = s - (f0 + f1); b0 = ex + f0; b1 = s;
}
__device__ __forceinline__ void ml_cummax2(float& p0, float& p1, int lane) {
    p1 = fmaxf(p0, p1); const float m = dpp_scan_max(p1);
    const float y = shup(m, 1, lane); const float ex = lane >= 1 ? y : -3.0e38f;
    p0 = fmaxf(p0, ex); p1 = fmaxf(p1, ex);
}
struct M1Raw { v4u k[2], v[4]; float ig[2], fg[2]; };
__device__ __forceinline__ void m1_fetch(M1Raw& R, const bf16* U, const float* GATES, int it, int tid, int lane, int wave) {
    const int j = it & (ML_NC - 1), h = (it >> 5) & 7, b = it >> 8; const size_t t0 = (size_t)b * SEQ + ML_L * j;
#pragma unroll
    for (int i = 0; i < 2; ++i) { const int p = tid + 512 * i, row = p >> 3, pc = p & 7; R.k[i] = *(const GAS v4u*)(U + (t0 + row) * PQK + 512 + h * 64 + pc * 8); }
#pragma unroll
    for (int i = 0; i < 4; ++i) { const int p = tid + 512 * i, row = p >> 4, pc = p & 15; R.v[i] = *(const GAS v4u*)(U + VO_OFF + (t0 + row) * PVO + h * 128 + pc * 8); }
    const int dir = wave & 1;
#pragma unroll
    for (int q = 0; q < 2; ++q) { const int lam = 2 * lane + q, tl = dir ? ML_L - 1 - lam : lam;
        R.ig[q] = GATES[(t0 + tl) * 32 + (2 * dir) * 8 + h]; R.fg[q] = GATES[(t0 + tl) * 32 + (2 * dir + 1) * 8 + h]; }
}
__device__ __forceinline__ void m1_mfma(Frame& F, const bf16* U, const float* GATES, bf16* DC, float* DN, float* SCg, float* SCm) {
    LAS unsigned char* kw0 = F.lds; LAS unsigned char* vT = F.lds + 36864; LAS float* wt = (LAS float*)(F.lds + 71680);
    const int tid = F.tid, lane = F.lane, fr = lane & 15, fq = lane >> 4;
    constexpr int NU = NB * 8 * ML_NC;
    M1Raw R;
    if (F.vcu < NU) m1_fetch(R, U, GATES, F.vcu, tid, lane, F.wave);
    for (int it = F.vcu; it < NU; it += F.G) {
        const int j = it & (ML_NC - 1), h = (it >> 5) & 7, b = it >> 8;
        __syncthreads();
        if (F.wave < 2) { const int dir = F.wave, c = dir ? ML_NC - 1 - j : j, cd = ((b * 8 + h) * 2 + dir) * ML_NC + c;
            float b0, b1; ml_cumsum2(log_sigmoid(R.fg[0]), log_sigmoid(R.fg[1]), lane, b0, b1);
            const float g = lane63(b1); const float w0 = g - b0 + R.ig[0], w1 = g - b1 + R.ig[1]; const float ml = lane63(dpp_scan_max(fmaxf(w0, w1)));
            const int l0 = 2 * lane, t0l = dir ? ML_L - 1 - l0 : l0, t1l = dir ? ML_L - 2 - l0 : l0 + 1;
            wt[dir * ML_L + t0l] = __expf(w0 - ml); wt[dir * ML_L + t1l] = __expf(w1 - ml);
            if (lane == 0) { SCg[cd] = g; SCm[cd] = ml; } }
#pragma unroll
        for (int i = 0; i < 4; ++i) { const int p = tid + 512 * i, row = p >> 4, pc = p & 15; *(LAS v4u*)(vT + row * ML_P + pc * 16) = R.v[i]; }
        __syncthreads();
#pragma unroll
        for (int i2 = 0; i2 < 2; ++i2) { const int p = tid + 512 * i2, row = p >> 3, pc = p & 7; const bf16x8 x = __builtin_bit_cast(bf16x8, R.k[i2]);
          *(LAS bf16x8*)(kw0 + row * ML_RS + pc * 16) = scale8(x, wt[row]); *(LAS bf16x8*)(kw0 + ML_L * ML_RS + row * ML_RS + pc * 16) = scale8(x, wt[ML_L + row]); }
        __syncthreads();
        if (it + F.G < NU) m1_fetch(R, U, GATES, it + F.G, tid, lane, F.wave);
        { const int dir = F.wave >> 2, g = F.wave & 3, c = dir ? ML_NC - 1 - j : j, cd = ((b * 8 + h) * 2 + dir) * ML_NC + c;
          LAS unsigned char* kw = kw0 + dir * ML_L * ML_RS;
          bf16x8 afr[4][4];
#pragma unroll
          for (int mf = 0; mf < 4; ++mf)
#pragma unroll
              for (int t = 0; t < 4; ++t) afr[mf][t] = lds_tr_frag(kw + (32 * t + 8 * fq + (fr >> 2)) * ML_RS + (16 * mf + 4 * (fr & 3)) * 2, 4 * ML_RS);
          LAS unsigned char* st = F.lds + 73728 + F.wave * 4608;
          const int nef = (g == 0) ? 3 : 2;
          for (int q = 0; q < nef; ++q) { const int ef = (q == 2) ? 8 : 2 * g + q;
              bf16x8 bfr[4];
#pragma unroll
              for (int t = 0; t < 4; ++t) { if (ef < 8) bfr[t] = lds_tr_frag(vT + (32 * t + 8 * fq + (fr >> 2)) * ML_P + (16 * ef + 4 * (fr & 3)) * 2, 4 * ML_P);
                  else { const short one = (fr == 0) ? (short)0x3F80 : (short)0; bfr[t] = (bf16x8){one, one, one, one, one, one, one, one}; } }
#pragma unroll
              for (int mf = 0; mf < 4; ++mf) { f32x4 acc = {0.f, 0.f, 0.f, 0.f};
#pragma unroll
                  for (int t = 0; t < 4; ++t) acc = MFMA16(afr[mf][t], bfr[t], acc);
                  const int d0 = 16 * mf + 4 * fq;
                  if (ef < 8) { v2u w; w.x = pg8::cvt_pk_bf16(acc[0], acc[1]); w.y = pg8::cvt_pk_bf16(acc[2], acc[3]); *(LAS v2u*)(st + (16 * q + fr) * ML_RS + d0 * 2) = w; }
                  else if (fr == 0) *(GAS f32x4*)(DN + (size_t)cd * 64 + d0) = acc; } }
          asm volatile("s_waitcnt lgkmcnt(0)" ::: "memory");
#pragma unroll
          for (int i = 0; i < 4; ++i) { const int er = 8 * i + (lane >> 3), c8 = lane & 7;
              *(GAS v4u*)(DC + (size_t)cd * 8192 + (32 * g + er) * 64 + 8 * c8) = *(const LAS v4u*)(st + er * ML_RS + c8 * 16); }
          asm volatile("s_waitcnt lgkmcnt(0)" ::: "memory"); }
    }
}
struct M3Raw { v4u q[2], k[2], v[4], cp[4]; float ig[2], fg[2], mp; };
__device__ __forceinline__ void m3_fetch(M3Raw& R, const bf16* U, const float* GATES, const float* SCp, const bf16* CP, int it, int tid, int lane, int gdir) {
    const int j = it & (ML_NC - 1), h = (it >> 5) & 7, b = it >> 8; const size_t t0 = (size_t)b * SEQ + ML_L * j;
#pragma unroll
    for (int i = 0; i < 2; ++i) { const int p = tid + 512 * i, row = p >> 3, pc = p & 7;
        R.q[i] = *(const GAS v4u*)(U + (t0 + row) * PQK + h * 64 + pc * 8); R.k[i] = *(const GAS v4u*)(U + (t0 + row) * PQK + 512 + h * 64 + pc * 8); }
#pragma unroll
    for (int i = 0; i < 4; ++i) { const int p = tid + 512 * i, row = p >> 4, pc = p & 15; R.v[i] = *(const GAS v4u*)(U + VO_OFF + (t0 + row) * PVO + h * 128 + pc * 8); }
    const int c = gdir ? ML_NC - 1 - j : j, cd = ((b * 8 + h) * 2 + gdir) * ML_NC + c;
#pragma unroll
    for (int q = 0; q < 2; ++q) { const int lam = 2 * lane + q, tl = gdir ? ML_L - 1 - lam : lam;
        R.ig[q] = GATES[(t0 + tl) * 32 + (2 * gdir) * 8 + h]; R.fg[q] = GATES[(t0 + tl) * 32 + (2 * gdir + 1) * 8 + h]; }
    R.mp = SCp[cd];
#pragma unroll
    for (int dd = 0; dd < 2; ++dd) { const int c2 = dd ? ML_NC - 1 - j : j; const size_t cd2 = (size_t)(((b * 8 + h) * 2 + dd) * ML_NC + c2);
#pragma unroll
        for (int i = 0; i < 2; ++i) { const int p = tid + 512 * i; R.cp[dd * 2 + i] = __builtin_nontemporal_load((const GAS v4u*)(CP + cd2 * 8192 + p * 8)); } }
}
__device__ __forceinline__ void m3_dir(f32x4 (&hsum)[8], const int dir, const LAS unsigned char* qS, const LAS unsigned char* kS, const LAS unsigned char* vT, const LAS float* tb,
                                       const LAS unsigned char* cS, const float* NPcd, const int lf, const int fr, const int fq, const int lane) {
    f32x4 npv[2][2];
#pragma unroll
    for (int kd = 0; kd < 2; ++kd) { const float* np = NPcd + 8 * fq + 32 * kd; npv[kd][0] = *(const GAS f32x4*)np; npv[kd][1] = *(const GAS f32x4*)(np + 4); }
    const int l = 16 * lf + fr; const float bl_l = tb[l], mo_l = tb[2 * ML_L + l], iw_l = tb[3 * ML_L + l];
    bf16x8 qb[2];
#pragma unroll
    for (int kd = 0; kd < 2; ++kd) qb[kd] = *(const LAS bf16x8*)(qS + l * ML_RS + (8 * fq + 32 * kd) * 2);
    bf16x8 pb[4];
#pragma unroll
    for (int t = 0; t < 4; ++t) { f32x4 pt[2];
#pragma unroll
        for (int hf = 0; hf < 2; ++hf) { const int srow = 32 * t + 8 * (fr >> 2) + 4 * hf + (fr & 3); f32x4 acc = {0.f, 0.f, 0.f, 0.f};
#pragma unroll
            for (int kd = 0; kd < 2; ++kd) acc = MFMA16(*(const LAS bf16x8*)(kS + srow * ML_RS + (8 * fq + 32 * kd) * 2), qb[kd], acc);
            const int s0 = 32 * t + 8 * fq + 4 * hf; const f32x4 bs = *(const LAS f32x4*)(tb + s0), is = *(const LAS f32x4*)(tb + ML_L + s0);
#pragma unroll
            for (int r = 0; r < 4; ++r) { const int s = s0 + r; const bool ok = dir ? (s >= l) : (s <= l); acc[r] = ok ? acc[r] * __expf(bl_l - bs[r] + is[r] - mo_l) : 0.f; }
            pt[hf] = acc; }
        pb[t] = pack8(pt[0], pt[1]); }
    bf16x8 qs[2]; qs[0] = scale8(qb[0], iw_l); qs[1] = scale8(qb[1], iw_l);
    float sc;
    { f32x4 acc = {0.f, 0.f, 0.f, 0.f}; const short one = (fr == 0) ? (short)0x3F80 : (short)0; const bf16x8 a1 = (bf16x8){one, one, one, one, one, one, one, one};
#pragma unroll
      for (int t = 0; t < 4; ++t) acc = MFMA16(a1, pb[t], acc);
#pragma unroll
      for (int kd = 0; kd < 2; ++kd) { const bf16x8 pk = pack8(npv[kd][0], npv[kd][1]); const bf16x8 a = (fr == 0) ? pk : (bf16x8){0, 0, 0, 0, 0, 0, 0, 0}; acc = MFMA16(a, qs[kd], acc); }
      const float den = shf(acc[0], fr); sc = 1.f / fmaxf(fabsf(den), __expf(-mo_l)); }
#pragma unroll
    for (int ef = 0; ef < 8; ++ef) { f32x4 acc = {0.f, 0.f, 0.f, 0.f};
        if ((ef & 3) == 0) __builtin_amdgcn_sched_barrier(0);
#pragma unroll
        for (int t = 0; t < 4; ++t) acc = MFMA16(lds_tr_frag(vT + (32 * t + 8 * fq + (fr >> 2)) * ML_P + (16 * ef + 4 * (fr & 3)) * 2, 4 * ML_P), pb[t], acc);
#pragma unroll
        for (int kd = 0; kd < 2; ++kd) acc = MFMA16(*(const LAS bf16x8*)(cS + (16 * ef + fr) * ML_RS + (8 * fq + 32 * kd) * 2), qs[kd], acc);
        hsum[ef] += acc * sc; }
}
__device__ __forceinline__ void m3_mfma(Frame& F, const bf16* U, const float* GATES, const bf16* CP, const float* NP, const float* SCp, const float* h_gain, bf16* MIX) {
    const int tid = F.tid, lane = F.lane, fr = lane & 15, fq = lane >> 4, lf = F.wave;
    LAS unsigned char* qS = F.lds; LAS unsigned char* kS = F.lds + 18432; LAS unsigned char* vT = F.lds + 36864; LAS float* tb2 = (LAS float*)(F.lds + 71680);
    const int gdir = lf & 1;
    constexpr int NU = NB * 8 * ML_NC;
    M3Raw R;
    LAS unsigned char* cS2 = F.lds + 75776;
    if (F.vcu < NU) m3_fetch(R, U, GATES, SCp, CP, F.vcu, tid, lane, gdir);
    for (int it = F.vcu; it < NU; it += F.G) {
        const int j = it & (ML_NC - 1), h = (it >> 5) & 7, b = it >> 8; const size_t t0 = (size_t)b * SEQ + ML_L * j;
        __syncthreads();
#pragma unroll
        for (int dd = 0; dd < 2; ++dd)
#pragma unroll
            for (int i = 0; i < 2; ++i) { const int p = tid + 512 * i, row = p >> 3, pc = p & 7; *(LAS v4u*)(cS2 + dd * 18432 + row * ML_RS + pc * 16) = R.cp[dd * 2 + i]; }
#pragma unroll
        for (int i = 0; i < 2; ++i) { const int p = tid + 512 * i, row = p >> 3, pc = p & 7; *(LAS v4u*)(qS + row * ML_RS + pc * 16) = R.q[i]; *(LAS v4u*)(kS + row * ML_RS + pc * 16) = R.k[i]; }
#pragma unroll
        for (int i = 0; i < 4; ++i) { const int p = tid + 512 * i, row = p >> 4, pc = p & 15; *(LAS v4u*)(vT + row * ML_P + pc * 16) = R.v[i]; }
        if (lf < 2) { LAS float* tb = tb2 + gdir * 4 * ML_L;
            float b0, b1; ml_cumsum2(log_sigmoid(R.fg[0]), log_sigmoid(R.fg[1]), lane, b0, b1);
            float p0 = R.ig[0] - b0, p1 = R.ig[1] - b1; ml_cummax2(p0, p1, lane);
            const float il0 = b0 + R.mp, il1 = b1 + R.mp, mo0 = fmaxf(il0, b0 + p0), mo1 = fmaxf(il1, b1 + p1);
            const int l0 = 2 * lane, t0l = gdir ? ML_L - 1 - l0 : l0, t1l = gdir ? ML_L - 2 - l0 : l0 + 1;
            tb[t0l] = b0; tb[ML_L + t0l] = R.ig[0]; tb[2 * ML_L + t0l] = mo0; tb[3 * ML_L + t0l] = __expf(il0 - mo0);
            tb[t1l] = b1; tb[ML_L + t1l] = R.ig[1]; tb[2 * ML_L + t1l] = mo1; tb[3 * ML_L + t1l] = __expf(il1 - mo1); }
        __syncthreads();
        if (it + F.G < NU) m3_fetch(R, U, GATES, SCp, CP, it + F.G, tid, lane, gdir);
        const int l = 16 * lf + fr;
        f32x4 hsum[8];
#pragma unroll
        for (int ef = 0; ef < 8; ++ef) hsum[ef] = (f32x4){0.f, 0.f, 0.f, 0.f};
#pragma unroll 1
        for (int dir = 0; dir < 2; ++dir) { const int c = dir ? ML_NC - 1 - j : j, cd = ((b * 8 + h) * 2 + dir) * ML_NC + c;
            m3_dir(hsum, dir, qS, kS, vT, tb2 + dir * 4 * ML_L, cS2 + dir * 18432, NP + (size_t)cd * 64, lf, fr, fq, lane); }
        { float ss = 0.f;
            v2u ov[8];
#pragma unroll
            for (int ef = 0; ef < 8; ++ef) ov[ef] = *(const GAS v2u*)(U + VO_OFF + (t0 + l) * PVO + 1024 + h * 128 + 16 * ef + 4 * fq);
#pragma unroll
            for (int ef = 0; ef < 8; ++ef) ss += (hsum[ef][0] * hsum[ef][0] + hsum[ef][1] * hsum[ef][1]) + (hsum[ef][2] * hsum[ef][2] + hsum[ef][3] * hsum[ef][3]);
            ss += shx(ss, 16, lane); ss += shx(ss, 32, lane);
            const float r = rsqrtf(ss * (1.f / 128.f) + RMS_EPS);
#pragma unroll
            for (int ef = 0; ef < 8; ++ef) { const int e = 16 * ef + 4 * fq; const f32x4 g = *(const GAS f32x4*)(h_gain + h * 128 + e);
                const float o0 = bflo(ov[ef].x), o1 = bfhi(ov[ef].x), o2 = bflo(ov[ef].y), o3 = bfhi(ov[ef].y);
                v2u w; w.x = pg8::cvt_pk_bf16(hsum[ef][0] * r * g[0] / (1.f + __expf(-o0)), hsum[ef][1] * r * g[1] / (1.f + __expf(-o1)));
                w.y = pg8::cvt_pk_bf16(hsum[ef][2] * r * g[2] / (1.f + __expf(-o2)), hsum[ef][3] * r * g[3] / (1.f + __expf(-o3)));
                *(GAS v2u*)(MIX + (t0 + l) * D + h * 128 + e) = w; } }
    }
}
__device__ __forceinline__ void na_mfma(Frame& F, const bf16* U, const float* rel_bias, bf16* MIX) {
    constexpr int KP = 144;
    LAS unsigned char* vI = F.lds; LAS float* bt = (LAS float*)(F.lds + 576 * KP + 128);
    const int tid = F.tid, lane = F.lane, fr = lane & 15, fq = lane >> 4, rsel = F.wave >> 2, jb = F.wave & 3;
    for (int it = F.vcu; it < NB * 8 * 32; it += F.G) {
        const int rp = it & 31, h = (it >> 5) & 7, b = it >> 8, r0 = 2 * rp;
        const int rs0 = min(max(r0 - 4, 0), 56);
        const int r = r0 + rsel, rs = min(max(r - 4, 0), 56), rowoff = rs - rs0, bs = min(max(16 * jb - 8, 0), 32);
        const int qc = 16 * jb + fr, ws0 = min(max(qc - 8, 0), 48); const size_t tq = (size_t)b * SEQ + r * 64 + qc;
        __syncthreads();
        if (tid < 465) bt[tid] = rel_bias[h * 465 + tid];
        v4u xv[9];
#pragma unroll
        for (int i = 0; i < 9; ++i) { const int p = tid + 512 * i, key = p >> 3, pc = p & 7, kr = min(rs0 + (key >> 6), 63); const size_t tk = (size_t)b * SEQ + kr * 64 + (key & 63);
            xv[i] = *(const GAS v4u*)(U + tk * PU + 1024 + h * 64 + pc * 8); }
        bf16x8 qb[2];
#pragma unroll
        for (int kd = 0; kd < 2; ++kd) qb[kd] = *(const GAS bf16x8*)(U + tq * PU + h * 64 + 8 * fq + 32 * kd);
        bf16x8 kf[8][2][2];
#pragma unroll
        for (int a = 0; a < 8; ++a)
#pragma unroll
            for (int hf = 0; hf < 2; ++hf) { const int c = 8 * (fr >> 2) + 4 * hf + (fr & 3); const size_t tk = (size_t)b * SEQ + (rs + a) * 64 + bs + c;
#pragma unroll
                for (int kd = 0; kd < 2; ++kd) kf[a][hf][kd] = *(const GAS bf16x8*)(U + tk * PU + 512 + h * 64 + 8 * fq + 32 * kd); }
#pragma unroll
        for (int i = 0; i < 9; ++i) { const int p = tid + 512 * i, key = p >> 3, pc = p & 7; *(LAS v4u*)(vI + key * KP + pc * 16) = xv[i]; }
        __syncthreads();
        f32x4 sc[8][2]; float mx = -3.0e38f;
        const int bidx0 = (rs - r + 7) * 31 + bs - qc + 15 + 8 * fq;
#pragma unroll
        for (int a2 = 0; a2 < 8; a2 += 4) {
            float bb[4][2][4];
#pragma unroll
            for (int a = 0; a < 4; ++a)
#pragma unroll
                for (int hf = 0; hf < 2; ++hf)
#pragma unroll
                    for (int rg = 0; rg < 4; ++rg) bb[a][hf][rg] = ((volatile LAS float*)bt)[bidx0 + 31 * (a2 + a) + 4 * hf + rg];
#pragma unroll
            for (int a = 0; a < 4; ++a)
#pragma unroll
                for (int hf = 0; hf < 2; ++hf) { f32x4 acc = {0.f, 0.f, 0.f, 0.f};
#pragma unroll
                    for (int kd = 0; kd < 2; ++kd) acc = MFMA16(kf[a2 + a][hf][kd], qb[kd], acc);
#pragma unroll
                    for (int rg = 0; rg < 4; ++rg) { const int kc = bs + 8 * fq + 4 * hf + rg; const bool ok = (kc >= ws0) && (kc < ws0 + 16);
                        const float v = ok ? acc[rg] + bb[a][hf][rg] : -3.0e38f; acc[rg] = v; mx = fmaxf(mx, v); }
                    sc[a2 + a][hf] = acc; } }
        mx = fmaxf(mx, shx(mx, 16, lane)); mx = fmaxf(mx, shx(mx, 32, lane));
        float sum = 0.f; bf16x8 pb[8];
#pragma unroll
        for (int a = 0; a < 8; ++a) {
#pragma unroll
            for (int hf = 0; hf < 2; ++hf)
#pragma unroll
                for (int rg = 0; rg < 4; ++rg) { const float p = (sc[a][hf][rg] > -1.0e38f) ? __expf(sc[a][hf][rg] - mx) : 0.f; sc[a][hf][rg] = p; sum += p; }
            pb[a] = pack8(sc[a][0], sc[a][1]); }
        sum += shx(sum, 16, lane); sum += shx(sum, 32, lane);
        const float inv = 1.f / sum;
        const LAS unsigned char* vrd = vI + (rowoff * 64 + bs + 8 * fq + (fr >> 2)) * KP + (fr & 3) * 8;
#pragma unroll
        for (int df = 0; df < 4; ++df) { f32x4 acc = {0.f, 0.f, 0.f, 0.f};
#pragma unroll
            for (int a = 0; a < 8; ++a) acc = MFMA16(lds_tr_frag(vrd + a * 64 * KP + df * 32, 4 * KP), pb[a], acc);
            v2u w; w.x = pg8::cvt_pk_bf16(acc[0] * inv, acc[1] * inv); w.y = pg8::cvt_pk_bf16(acc[2] * inv, acc[3] * inv);
            *(v2u*)(MIX + tq * D + h * 64 + 16 * df + 4 * fq) = w; }
    }
}

__device__ __forceinline__ void fourier1_mfma(Frame& F, const bf16* U, bf16* Y2, const LAS float* cs) {
    LAS unsigned char* T1 = F.lds; LAS unsigned char* xt = F.lds + 16384 + F.wave * 9216;
    const int tid = F.tid, lane = F.lane, fr = lane & 15, fq = lane >> 4;
    __syncthreads();
    for (int e = tid; e < 1024; e += 512) { const int ln = e & 63, ks = (e >> 6) & 1, nf = e >> 7, col = 16 * nf + (ln & 15), u = col & 63, im = col >> 6; float v[8];
#pragma unroll
        for (int j = 0; j < 8; ++j) { const int a = 8 * (ln >> 4) + j + 32 * ks, k = (a * u) & 63; v[j] = cs[(im ? 64 : 0) + k] * (im ? -1.f : 1.f); }
        *(LAS bf16x8*)(T1 + e * 16) = pack8((f32x4){v[0], v[1], v[2], v[3]}, (f32x4){v[4], v[5], v[6], v[7]}); }
    __syncthreads();
    for (int it = F.vcu * 8 + F.wave; it < NB * 8 * 64; it += F.G * 8) {
        const int b = it & 63, g = (it >> 6) & 7, bt = it >> 9;
#pragma unroll
        for (int i = 0; i < 8; ++i) { const int p = lane + 64 * i, a = p >> 3, pc = p & 7;
            const v4u x = *(const v4u*)(U + ((size_t)bt * SEQ + 64 * a + b) * PU + 1536 + 64 * g + 8 * pc);
            LAS unsigned short* d = (LAS unsigned short*)(xt + (pc * 8) * ML_RS + a * 2);
            d[0 * (ML_RS / 2)] = (unsigned short)(x.x & 0xffff); d[1 * (ML_RS / 2)] = (unsigned short)(x.x >> 16);
            d[2 * (ML_RS / 2)] = (unsigned short)(x.y & 0xffff); d[3 * (ML_RS / 2)] = (unsigned short)(x.y >> 16);
            d[4 * (ML_RS / 2)] = (unsigned short)(x.z & 0xffff); d[5 * (ML_RS / 2)] = (unsigned short)(x.z >> 16);
            d[6 * (ML_RS / 2)] = (unsigned short)(x.w & 0xffff); d[7 * (ML_RS / 2)] = (unsigned short)(x.w >> 16); }
        asm volatile("s_waitcnt lgkmcnt(0)" ::: "memory");
        float tc[4], ts[4];
#pragma unroll
        for (int nfp = 0; nfp < 4; ++nfp) __sincosf(6.283185307179586f * (float)(b * (16 * nfp + fr)) * (1.f / 4096.f), &ts[nfp], &tc[nfp]);
        bf16* yb = Y2 + (size_t)(bt * 8 + g) * 64 * 64 * 128 + (size_t)b * 128;
#pragma unroll
        for (int mf = 0; mf < 4; ++mf) { bf16x8 af[2];
#pragma unroll
            for (int ks = 0; ks < 2; ++ks) af[ks] = *(const LAS bf16x8*)(xt + (16 * mf + fr) * ML_RS + (32 * ks + 8 * fq) * 2);
#pragma unroll
            for (int nfp = 0; nfp < 4; ++nfp) { f32x4 re = {0.f, 0.f, 0.f, 0.f}, im = {0.f, 0.f, 0.f, 0.f};
#pragma unroll
                for (int ks = 0; ks < 2; ++ks) { re = MFMA16(af[ks], *(const LAS bf16x8*)(T1 + ((nfp * 2 + ks) * 64 + lane) * 16), re);
                    im = MFMA16(af[ks], *(const LAS bf16x8*)(T1 + (((nfp + 4) * 2 + ks) * 64 + lane) * 16), im); }
                const float c = tc[nfp] * 0.125f, sn = ts[nfp] * 0.125f; const int u = 16 * nfp + fr;
                v2u wr, wi; wr.x = pg8::cvt_pk_bf16(re[0] * c + im[0] * sn, re[1] * c + im[1] * sn); wr.y = pg8::cvt_pk_bf16(re[2] * c + im[2] * sn, re[3] * c + im[3] * sn);
                wi.x = pg8::cvt_pk_bf16(im[0] * c - re[0] * sn, im[1] * c - re[1] * sn); wi.y = pg8::cvt_pk_bf16(im[2] * c - re[2] * sn, im[3] * c - re[3] * sn);
                bf16* yp = yb + (size_t)u * 64 * 128 + 16 * mf + 4 * fq;
                *(v2u*)yp = wr; *(v2u*)(yp + 64) = wi; } }
        asm volatile("s_waitcnt lgkmcnt(0)" ::: "memory");
    }
}
__device__ __forceinline__ void fourier2_mfma(Frame& F, const bf16* Y2, bf16* MIX, const LAS float* cs) {
    LAS unsigned char* T2 = F.lds; LAS unsigned char* T3 = F.lds + 32768;
    const int tid = F.tid, lane = F.lane, fr = lane & 15, fq = lane >> 4;
    __syncthreads();
    for (int e = tid; e < 2048; e += 512) { const int ln = e & 63, ks = (e >> 6) & 3, nf = e >> 8, col = 16 * nf + (ln & 15), cp = col & 63, imo = col >> 6, imi = ks >> 1; float v[8];
#pragma unroll
        for (int j = 0; j < 8; ++j) { const int c = 32 * (ks & 1) + 8 * (ln >> 4) + j, k = (c * cp) & 63; v[j] = cs[((imi == imo) ? 0 : 64) + k] * ((imi == imo || imi) ? 1.f : -1.f); }
        *(LAS bf16x8*)(T2 + e * 16) = pack8((f32x4){v[0], v[1], v[2], v[3]}, (f32x4){v[4], v[5], v[6], v[7]}); }
    for (int e = tid; e < 1024; e += 512) { const int ln = e & 63, ks = (e >> 6) & 3, vf = e >> 8, vv = 16 * vf + (ln & 15), im = ks >> 1, t = ks & 1; float v[8];
#pragma unroll
        for (int j = 0; j < 8; ++j) { const int bb = 32 * t + 16 * (j >> 2) + 4 * (ln >> 4) + (j & 3), k = (vv * bb) & 63; v[j] = cs[(im ? 64 : 0) + k]; }
        *(LAS bf16x8*)(T3 + e * 16) = pack8((f32x4){v[0], v[1], v[2], v[3]}, (f32x4){v[4], v[5], v[6], v[7]}); }
    __syncthreads();
    for (int it = F.vcu * 8 + F.wave; it < NB * 8 * 64; it += F.G * 8) {
        const int u = it & 63, g = (it >> 6) & 7, bt = it >> 9;
        const bf16* yb = Y2 + ((size_t)(bt * 8 + g) * 64 + u) * 64 * 128;
        bf16x8 af[4][4];
#pragma unroll
        for (int mf = 0; mf < 4; ++mf)
#pragma unroll
            for (int ks = 0; ks < 4; ++ks) af[mf][ks] = __builtin_nontemporal_load((const bf16x8*)(yb + (size_t)(16 * mf + fr) * 128 + (ks >> 1) * 64 + 32 * (ks & 1) + 8 * fq));
#pragma unroll 1
        for (int nfp = 0; nfp < 4; ++nfp) {
            f32x4 wre[4], wim[4];
#pragma unroll
            for (int mf = 0; mf < 4; ++mf) { f32x4 re = {0.f, 0.f, 0.f, 0.f}, im = {0.f, 0.f, 0.f, 0.f};
#pragma unroll
                for (int ks = 0; ks < 4; ++ks) { re = MFMA16(af[mf][ks], *(const LAS bf16x8*)(T2 + ((nfp * 4 + ks) * 64 + lane) * 16), re);
                    im = MFMA16(af[mf][ks], *(const LAS bf16x8*)(T2 + (((nfp + 4) * 4 + ks) * 64 + lane) * 16), im); }
                wre[mf] = re; wim[mf] = im; }
            bf16x8 ap[4]; ap[0] = pack8(wre[0], wre[1]); ap[1] = pack8(wre[2], wre[3]); ap[2] = pack8(wim[0], wim[1]); ap[3] = pack8(wim[2], wim[3]);
#pragma unroll
            for (int vf = 0; vf < 4; ++vf) { f32x4 z = {0.f, 0.f, 0.f, 0.f};
#pragma unroll
                for (int ks = 0; ks < 4; ++ks) z = MFMA16(ap[ks], *(const LAS bf16x8*)(T3 + ((vf * 4 + ks) * 64 + lane) * 16), z);
                const size_t tok = (size_t)bt * SEQ + u + 64 * (16 * vf + fr);
                v2u w; w.x = pg8::cvt_pk_bf16(z[0] * (1.f / 64.f), z[1] * (1.f / 64.f)); w.y = pg8::cvt_pk_bf16(z[2] * (1.f / 64.f), z[3] * (1.f / 64.f));
                *(v2u*)(MIX + tok * D + 512 + 64 * g + 16 * nfp + 4 * fq) = w; }
        }
    }
}

template <bool RB>
__device__ __forceinline__ void router_mfma(Frame& F, const void* resid_, bf16* X1o, const float* gain, const bf16* WR, const float* b_rg, const float* b_re,
                                            const bf16* XN, bf16* XNo, int* eid, float* gate, int* rel, unsigned* cnt, int* list) {
    const int lane = F.lane, fr = lane & 15, fq = lane >> 4, w = F.wave, tid = F.tid;
    LAS float* ssp = (LAS float*)F.lds; LAS float* Lp = (LAS float*)(F.lds + 1024); LAS float* Ls = (LAS float*)(F.lds + 1024 + 25088);
    f32x4 ga[4], gb[4];
#pragma unroll
    for (int s = 0; s < 4; ++s) { ga[s] = *(const GAS f32x4*)(gain + 128 * w + 32 * s + 8 * fq); gb[s] = *(const GAS f32x4*)(gain + 128 * w + 32 * s + 8 * fq + 4); }
    bf16x8 wf[4][3];
#pragma unroll
    for (int s = 0; s < 4; ++s)
#pragma unroll
        for (int nf = 0; nf < 3; ++nf) wf[s][nf] = *(const GAS bf16x8*)(WR + (size_t)(16 * nf + fr) * D + 128 * w + 32 * s + 8 * fq);
    LAS int* tokE = (LAS int*)(F.lds + 32768); LAS float* tokG = (LAS float*)(F.lds + 32768 + 1024);
    int gi = 0;
    const float* resid = (const float*)resid_; const bf16* residb = (const bf16*)resid_;
    f32x4 na[4], nb[4]; v4u nd[4], nr[4];
    { const size_t row = (size_t)F.vcu * 16 + fr; const size_t ro = row * D + 128 * w + 8 * fq; const bf16* dl = XN + ro;
#pragma unroll
      for (int s = 0; s < 4; ++s) { if (RB) nr[s] = __builtin_nontemporal_load((const GAS v4u*)(residb + ro + 32 * s)); else { na[s] = __builtin_nontemporal_load((const GAS f32x4*)(resid + ro + 32 * s)); nb[s] = __builtin_nontemporal_load((const GAS f32x4*)(resid + ro + 32 * s + 4)); }
          nd[s] = __builtin_nontemporal_load((const GAS v4u*)(dl + 32 * s)); } }
    for (int it = F.vcu; it < T / 16; it += F.G) {
        const size_t row = (size_t)it * 16 + fr; bf16* xo = X1o + row * D + 128 * w + 8 * fq;
        f32x4 xa[4], xb[4]; float ss = 0.f;
#pragma unroll
        for (int s = 0; s < 4; ++s) { const v4u p = nd[s];
            if (RB) { const v4u q = nr[s]; xa[s] = (f32x4){bflo(q.x), bfhi(q.x), bflo(q.y), bfhi(q.y)}; xb[s] = (f32x4){bflo(q.z), bfhi(q.z), bflo(q.w), bfhi(q.w)}; } else { xa[s] = na[s]; xb[s] = nb[s]; }
            xa[s][0] += bflo(p.x); xa[s][1] += bfhi(p.x); xa[s][2] += bflo(p.y); xa[s][3] += bfhi(p.y); xb[s][0] += bflo(p.z); xb[s][1] += bfhi(p.z); xb[s][2] += bflo(p.w); xb[s][3] += bfhi(p.w); }
        if (it + F.G < T / 16) { const size_t nrow = (size_t)(it + F.G) * 16 + fr; const size_t ro = nrow * D + 128 * w + 8 * fq; const bf16* dl = XN + ro;
#pragma unroll
            for (int s = 0; s < 4; ++s) { if (RB) nr[s] = __builtin_nontemporal_load((const GAS v4u*)(residb + ro + 32 * s)); else { na[s] = __builtin_nontemporal_load((const GAS f32x4*)(resid + ro + 32 * s)); nb[s] = __builtin_nontemporal_load((const GAS f32x4*)(resid + ro + 32 * s + 4)); }
                nd[s] = __builtin_nontemporal_load((const GAS v4u*)(dl + 32 * s)); } }
#pragma unroll
        for (int s = 0; s < 4; ++s) { const bf16x8 xq = pack8(xa[s], xb[s]); *(GAS bf16x8*)(xo + 32 * s) = xq;
            const v4u q = __builtin_bit_cast(v4u, xq); xa[s] = (f32x4){bflo(q.x), bfhi(q.x), bflo(q.y), bfhi(q.y)}; xb[s] = (f32x4){bflo(q.z), bfhi(q.z), bflo(q.w), bfhi(q.w)}; }
#pragma unroll
        for (int s = 0; s < 4; ++s) { const f32x4 a = xa[s], b = xb[s]; ss += (a[0] * a[0] + a[1] * a[1]) + (a[2] * a[2] + a[3] * a[3]) + (b[0] * b[0] + b[1] * b[1]) + (b[2] * b[2] + b[3] * b[3]); }
        ss += shx(ss, 16, lane); ss += shx(ss, 32, lane);
        __syncthreads();
        if (fq == 0) ssp[w * 16 + fr] = ss;
        __syncthreads();
        float tot = 0.f;
#pragma unroll
        for (int q = 0; q < 8; ++q) tot += ssp[q * 16 + fr];
        const float r = rsqrtf(tot * (1.f / D) + RMS_EPS);
        f32x4 acc[3] = {{0.f, 0.f, 0.f, 0.f}, {0.f, 0.f, 0.f, 0.f}, {0.f, 0.f, 0.f, 0.f}};
#pragma unroll
        for (int s = 0; s < 4; ++s) { const bf16x8 af = pack8(xa[s] * r * ga[s], xb[s] * r * gb[s]);
            *(GAS bf16x8*)(XNo + row * D + 128 * w + 32 * s + 8 * fq) = af;
#pragma unroll
            for (int nf = 0; nf < 3; ++nf) acc[nf] = MFMA16(af, wf[s][nf], acc[nf]); }
#pragma unroll
        for (int nf = 0; nf < 3; ++nf)
#pragma unroll
            for (int rg = 0; rg < 4; ++rg) Lp[(w * 16 + 4 * fq + rg) * 49 + 16 * nf + fr] = acc[nf][rg];
        __syncthreads();
        for (int i = tid; i < 16 * 48; i += 512) { const int tk = i / 48, n = i % 48; float v = 0.f;
#pragma unroll
            for (int q = 0; q < 8; ++q) v += Lp[(q * 16 + tk) * 49 + n];
            Ls[tk * 49 + n] = v; }
        __syncthreads();
        if (tid < 16) { const int t = it * 16 + tid; const LAS float* lp = Ls + tid * 49;
            float lg[4]; int gs = 0; float gm = -3.0e38f;
#pragma unroll
            for (int q = 0; q < 4; ++q) { lg[q] = lp[q] + b_rg[q]; if (lg[q] > gm) { gm = lg[q]; gs = q; } }
            float gden = 0.f;
#pragma unroll
            for (int q = 0; q < 4; ++q) gden += __expf(lg[q] - gm);
            const float p_top = 1.f / gden;
            float m0 = -3.0e38f, m1 = -3.0e38f; int i0 = 0, i1 = 0;
#pragma unroll
            for (int q = 0; q < 8; ++q) { const float v = lp[4 + gs * 8 + q] + b_re[gs * 8 + q];
                if (v > m0) { m1 = m0; i1 = i0; m0 = v; i0 = q; } else if (v > m1) { m1 = v; i1 = q; } }
            const float e1 = __expf(m1 - m0), inv = 1.f / (1.f + e1);
            tokE[(gi * 16 + tid) * 2] = gs * 8 + i0; tokE[(gi * 16 + tid) * 2 + 1] = gs * 8 + i1; tokG[(gi * 16 + tid) * 2] = p_top * inv; tokG[(gi * 16 + tid) * 2 + 1] = p_top * e1 * inv; }
        ++gi;
    }
    __syncthreads();
    if (w == 0) { const bool live = lane < gi * 16; const int a0 = live ? tokE[lane * 2] : -1, a1 = live ? tokE[lane * 2 + 1] : -1;
        const unsigned long long lt = (1ull << lane) - 1ull; int r0 = 0, r1 = 0, mycount = 0;
        for (int e = 0; e < NE; ++e) { const unsigned long long m0 = __ballot(a0 == e), m1 = __ballot(a1 == e);
            if (a0 == e) r0 = __popcll(m0 & lt); if (a1 == e) r1 = __popcll(m0) + __popcll(m1 & lt); if (lane == e) mycount = __popcll(m0) + __popcll(m1); }
        int base = 0; if (lane < NE && mycount > 0) base = (int)__hip_atomic_fetch_add(cnt + 64 * lane, (unsigned)mycount, RLX_AGENT);
        const int b0 = shfi(base, a0 < 0 ? 0 : a0), b1 = shfi(base, a1 < 0 ? 0 : a1);
        if (live) { const int t = (F.vcu + (lane >> 4) * F.G) * 16 + (lane & 15); const int sa = b0 + r0, sb = b1 + r1;
            list[a0 * 16384 + sa] = t; list[a1 * 16384 + sb] = t;
            eid[2 * t] = a0; eid[2 * t + 1] = a1; rel[2 * t] = sa; rel[2 * t + 1] = sb; gate[2 * t] = tokG[lane * 2]; gate[2 * t + 1] = tokG[lane * 2 + 1]; } }
}
__device__ __forceinline__ void combine_gates_mfma(Frame& F, bf16* X1, const bf16* Y, const int* eid, const float* gate, const int* rel, const float* gain, bf16* XN,
                                                   const bf16* WGt, const float* gate_bias, float* GATES) {
    const int lane = F.lane, fr = lane & 15, fq = lane >> 4, w = F.wave, tid = F.tid;
    LAS const int* tab = (LAS const int*)(F.lds + MOE_TAB_OFF);
    LAS float* ssp = (LAS float*)F.lds; LAS float* Lp = (LAS float*)(F.lds + 1024);
    f32x4 ga[4], gb[4];
#pragma unroll
    for (int s = 0; s < 4; ++s) { ga[s] = *(const GAS f32x4*)(gain + 128 * w + 32 * s + 8 * fq); gb[s] = *(const GAS f32x4*)(gain + 128 * w + 32 * s + 8 * fq + 4); }
    bf16x8 wf[4][2];
#pragma unroll
    for (int s = 0; s < 4; ++s)
#pragma unroll
        for (int nf = 0; nf < 2; ++nf) wf[s][nf] = *(const GAS bf16x8*)(WGt + (size_t)(16 * nf + fr) * D + 128 * w + 32 * s + 8 * fq);
    v4u nxr[4], np0[4], np1[4]; float ng0, ng1;
    { const size_t row = (size_t)F.vcu * 16 + fr; const bf16* xr = X1 + row * D + 128 * w + 8 * fq;
      const bf16* y0 = Y + (size_t)(256 * tab[eid[2 * row]] + rel[2 * row]) * D + 128 * w + 8 * fq; const bf16* y1 = Y + (size_t)(256 * tab[eid[2 * row + 1]] + rel[2 * row + 1]) * D + 128 * w + 8 * fq;
      ng0 = gate[2 * row]; ng1 = gate[2 * row + 1];
#pragma unroll
      for (int s = 0; s < 4; ++s) { nxr[s] = __builtin_nontemporal_load((const GAS v4u*)(xr + 32 * s)); np0[s] = __builtin_nontemporal_load((const GAS v4u*)(y0 + 32 * s)); np1[s] = __builtin_nontemporal_load((const GAS v4u*)(y1 + 32 * s)); } }
    for (int it = F.vcu; it < T / 16; it += F.G) {
        const size_t row = (size_t)it * 16 + fr; bf16* xr = X1 + row * D + 128 * w + 8 * fq;
        const float g0 = ng0, g1 = ng1;
        f32x4 xa[4], xb[4]; v4u pp[4], qq[4]; float ss = 0.f;
#pragma unroll
        for (int s = 0; s < 4; ++s) { const v4u q = nxr[s]; xa[s] = (f32x4){bflo(q.x), bfhi(q.x), bflo(q.y), bfhi(q.y)}; xb[s] = (f32x4){bflo(q.z), bfhi(q.z), bflo(q.w), bfhi(q.w)}; pp[s] = np0[s]; qq[s] = np1[s]; }
        if (it + F.G < T / 16) { const size_t nrow = (size_t)(it + F.G) * 16 + fr; const bf16* nx = X1 + nrow * D + 128 * w + 8 * fq;
            const bf16* y0 = Y + (size_t)(256 * tab[eid[2 * nrow]] + rel[2 * nrow]) * D + 128 * w + 8 * fq; const bf16* y1 = Y + (size_t)(256 * tab[eid[2 * nrow + 1]] + rel[2 * nrow + 1]) * D + 128 * w + 8 * fq;
            ng0 = gate[2 * nrow]; ng1 = gate[2 * nrow + 1];
#pragma unroll
            for (int s = 0; s < 4; ++s) { nxr[s] = __builtin_nontemporal_load((const GAS v4u*)(nx + 32 * s)); np0[s] = __builtin_nontemporal_load((const GAS v4u*)(y0 + 32 * s)); np1[s] = __builtin_nontemporal_load((const GAS v4u*)(y1 + 32 * s)); } }
#pragma unroll
        for (int s = 0; s < 4; ++s) { f32x4 a = xa[s], b = xb[s]; const v4u p = pp[s], q = qq[s];
            a[0] += g0 * bflo(p.x) + g1 * bflo(q.x); a[1] += g0 * bfhi(p.x) + g1 * bfhi(q.x); a[2] += g0 * bflo(p.y) + g1 * bflo(q.y); a[3] += g0 * bfhi(p.y) + g1 * bfhi(q.y);
            b[0] += g0 * bflo(p.z) + g1 * bflo(q.z); b[1] += g0 * bfhi(p.z) + g1 * bfhi(q.z); b[2] += g0 * bflo(p.w) + g1 * bflo(q.w); b[3] += g0 * bfhi(p.w) + g1 * bfhi(q.w);
            { const bf16x8 xq = pack8(a, b); *(GAS bf16x8*)(xr + 32 * s) = xq; const v4u q2 = __builtin_bit_cast(v4u, xq);
              a = (f32x4){bflo(q2.x), bfhi(q2.x), bflo(q2.y), bfhi(q2.y)}; b = (f32x4){bflo(q2.z), bfhi(q2.z), bflo(q2.w), bfhi(q2.w)}; }
            xa[s] = a; xb[s] = b;
            ss += (a[0] * a[0] + a[1] * a[1]) + (a[2] * a[2] + a[3] * a[3]) + (b[0] * b[0] + b[1] * b[1]) + (b[2] * b[2] + b[3] * b[3]); }
        ss += shx(ss, 16, lane); ss += shx(ss, 32, lane);
        __syncthreads();
        if (fq == 0) ssp[w * 16 + fr] = ss;
        __syncthreads();
        float tot = 0.f;
#pragma unroll
        for (int q = 0; q < 8; ++q) tot += ssp[q * 16 + fr];
        const float r = rsqrtf(tot * (1.f / D) + RMS_EPS);
        f32x4 acc[2] = {{0.f, 0.f, 0.f, 0.f}, {0.f, 0.f, 0.f, 0.f}};
#pragma unroll
        for (int s = 0; s < 4; ++s) { const bf16x8 af = pack8(xa[s] * r * ga[s], xb[s] * r * gb[s]);
            *(GAS bf16x8*)(XN + row * D + 128 * w + 32 * s + 8 * fq) = af;
#pragma unroll
            for (int nf = 0; nf < 2; ++nf) acc[nf] = MFMA16(af, wf[s][nf], acc[nf]); }
#pragma unroll
        for (int nf = 0; nf < 2; ++nf)
#pragma unroll
            for (int rg = 0; rg < 4; ++rg) Lp[(w * 16 + 4 * fq + rg) * 33 + 16 * nf + fr] = acc[nf][rg];
        __syncthreads();
        { const int tk = tid >> 5, n = tid & 31; float v = 0.f;
#pragma unroll
          for (int q = 0; q < 8; ++q) v += Lp[(q * 16 + tk) * 33 + n];
          GATES[((size_t)it * 16 + tk) * 32 + n] = v + gate_bias[n]; }
    }
}
__device__ __forceinline__ void thin_weights(Frame& F, const float* w_rg, const float* w_re, const float* od_w_in, bf16* WR, bf16* WGt, int wg, int nwg) {
    const int gt = wg * 512 + F.tid, NT = nwg * 512;
    for (int i = gt; i < 2 * 48 * 1024; i += NT) { const int k = i & 1023, n = (i >> 10) % 48, l = i / (48 * 1024);
        const float v = n < 4 ? w_rg[((size_t)l * D + k) * 4 + n] : (n < 36 ? w_re[((size_t)l * D + k) * 32 + n - 4] : 0.f);
        WR[i] = (bf16)f2bf(v); }
    for (int i = gt; i < 32 * 1024; i += NT) { const int k = i & 1023, n = i >> 10; WGt[i] = (bf16)f2bf(od_w_in[(size_t)k * OD_IN + OD_INP + n]); }
}

__device__ __forceinline__ const void* karg_ptr(int byte_off) {
    const void* r; const char* ks = (const char*)__builtin_amdgcn_kernarg_segment_ptr();
    asm volatile("s_load_dwordx2 %0, %1, %2\n\ts_waitcnt lgkmcnt(0)" : "=s"(r) : "s"(ks), "i"(byte_off) : "memory");
    return r;
}
#define KIN(i) ((const float*)karg_ptr(8 * (i)))
#define KOUT() ((float*)karg_ptr(160))
#define KWS() ((unsigned char*)karg_ptr(168))

__global__ void __launch_bounds__(512, 2) mk_fwd(Args args) {
    extern __shared__ __attribute__((aligned(16))) unsigned char lds_raw[];
    {   LAS unsigned char* l0 = (LAS unsigned char*)lds_raw;
        for (int u = threadIdx.x; u < (LDS_BYTES - LDSCTL_OFF) / 4; u += 512) ((LAS unsigned*)(l0 + LDSCTL_OFF))[u] = 0u;
        __syncthreads();
        if (!MK_PER_PHASE) (void)xcd_barrier_post((unsigned*)(KWS() + WS_CTL) + CW_BAR, (volatile LAS unsigned*)(l0 + MISC_OFF) + 8); }
    const int hi = args.ph_hi;
    const int wv0 = __builtin_amdgcn_readfirstlane((int)(threadIdx.x >> 6));
#ifdef ONLY
#define CASE(k) case (k): if ((k) != ONLY) break;
#define CASE2(a, b) case (a): case (b): if ((a) != ONLY) break;
#else
#define CASE(k) case (k):
#define CASE2(a, b) case (a): case (b):
#endif

    int redo = 0, pass = 0;
#ifndef PROBE_PREFIX
#define PROBE_PREFIX (-1)
#endif
    const int nsteps = hi + ((PROBE_PREFIX >= 0 && !MK_PER_PHASE) ? PROBE_PREFIX + 1 : 0);
#pragma unroll 1
    for (int step = args.ph_lo; step < nsteps; ++step) {
        int ph = step; if (step >= hi) { ph = step - hi; pass = 1; }
        Frame F;
        { int mb; asm volatile("v_mbcnt_lo_u32_b32 %0, -1, 0\n\tv_mbcnt_hi_u32_b32 %0, -1, %0" : "=v"(mb));
          int t = wv0 * 64 + mb; asm volatile("" : "+v"(t)); int bx = blockIdx.x, G = gridDim.x; asm volatile("" : "+s"(bx), "+s"(G));
          F.lds = (LAS unsigned char*)lds_raw; F.MISC = (volatile LAS unsigned*)(F.lds + MISC_OFF);
          F.tid = t; F.lane = t & 63; F.wave = __builtin_amdgcn_readfirstlane(t >> 6); F.G = G; F.vcu = (G % 8 == 0) ? (bx % 8) * (G / 8) + bx / 8 : bx; F.bx = bx; }
        LAS float* cs = (LAS float*)(F.lds + 100000);
        unsigned char* ws = KWS();
        const int layer = ph >= 14 ? 1 : 0;
        unsigned* cnt = (unsigned*)(ws + WS_CTL) + CW_CNT + ((layer * 2 + pass) * 32) * 64;
        switch (ph) {
        CASE(0) {
            convert_weights(F, KIN(2), 1024, 2048, 2048, 0, (bf16*)(ws + WS_WEVIN), 0, 1);
            const float* x = KIN(0); const float* ev_norm = KIN(1); bf16* XN = (bf16*)(ws + WS_XN);
            for (int m = F.vcu * 8 + F.wave; m < T; m += 2 * F.G * 8) { const int m2 = (m + F.G * 8 < T) ? m + F.G * 8 : m;
                rms_rows2_to_bf16(F.lane, x + (size_t)m * D, x + (size_t)m2 * D, ev_norm, XN + (size_t)m * D, XN + (size_t)m2 * D); }
            if (F.bx == 0) ((unsigned*)(XN + (size_t)T * D))[F.tid] = 0u;
        } break;
        CASE(1) {
#ifndef MK_CONV_DIV
#define MK_CONV_DIV 2
#define MK_CONV_NUM 1
#endif
            if ((F.vcu % MK_CONV_DIV) < MK_CONV_NUM) { const int cgw = ((F.vcu / MK_CONV_DIV) * MK_CONV_NUM + (F.vcu % MK_CONV_DIV)) * 8 + F.wave, cn = ((F.G / MK_CONV_DIV) * MK_CONV_NUM + min(F.G % MK_CONV_DIV, MK_CONV_NUM)) * 8;
                { const ConvSeg sg[6] = { {KIN(6), (bf16*)(ws + WS_WEVOUT), 1024, 1024, 1024, 1, 0, 0},
                                          {KIN(17), (bf16*)(ws + WS_WG), 1024, 512, 512, 32, (size_t)1024 * 512, (size_t)512 * 1024},
                                          {KIN(18), (bf16*)(ws + WS_WU), 1024, 512, 512, 32, (size_t)1024 * 512, (size_t)512 * 1024},
                                          {KIN(19), (bf16*)(ws + WS_WD), 512, 1024, 1024, 32, (size_t)512 * 1024, (size_t)1024 * 512},
                                          {KIN(8), (bf16*)(ws + WS_WODIN), 1024, 3072, OD_IN, 1, 0, 0},
                                          {KIN(11), (bf16*)(ws + WS_WODOUT), 1024, 1024, 1024, 1, 0, 0} };
                  convert_multi<6>(F, sg, cgw, cn); }
                thin_weights(F, KIN(13), KIN(15), KIN(8), (bf16*)(ws + WS_WR), (bf16*)(ws + WS_WGT), (F.vcu / MK_CONV_DIV) * MK_CONV_NUM + (F.vcu % MK_CONV_DIV), (F.G / MK_CONV_DIV) * MK_CONV_NUM + min(F.G % MK_CONV_DIV, MK_CONV_NUM));
                __syncthreads(); }
            ProbDenseDyn P; P.K = 1024; P.A = (const char*)(ws + WS_XN); P.Bt = (const char*)(ws + WS_WEVIN); P.ord.init(T, EV_IN, F.G, F.bx); P.bhalf_rows = 32;
            P.head = (unsigned*)(ws + WS_CTL) + CW_QDENSE + ((0 * 2 + pass) * 8) * 64; P.slot = (LAS int*)(F.lds + MOE_SLOT_OFF + 32); P.xlab = F.bx & 7;
            EpiEvIn E{(bf16*)(ws + WS_U), KIN(3), KIN(4)};
            pg8::gemm_phase(F.lds, P, E, F.tid);
        } break;
        CASE(2) {
            if (F.tid < 64) { float sn, c; __sincosf(6.283185307179586f * (float)F.tid * (1.f / 64.f), &sn, &c); cs[F.tid] = c; cs[64 + F.tid] = sn; }
            __syncthreads();
            na_mfma(F, (const bf16*)(ws + WS_U), KIN(5), (bf16*)(ws + WS_MIX));
            __syncthreads();
            if (F.tid < 64) { float sn, c; __sincosf(6.283185307179586f * (float)F.tid * (1.f / 64.f), &sn, &c); cs[F.tid] = c; cs[64 + F.tid] = sn; }
            __syncthreads();
            fourier1_mfma(F, (const bf16*)(ws + WS_U), (bf16*)(ws + WS_Y2), cs);
        } break;
        CASE(3) {
            if (F.tid < 64) { float sn, c; __sincosf(6.283185307179586f * (float)F.tid * (1.f / 64.f), &sn, &c); cs[F.tid] = c; cs[64 + F.tid] = sn; }
            __syncthreads();
            fourier2_mfma(F, (const bf16*)(ws + WS_Y2), (bf16*)(ws + WS_MIX), cs);
        } break;
        CASE(4) {
            ProbDense P; P.K = 1024; P.A = (const char*)(ws + WS_MIX); P.Bt = (const char*)(ws + WS_WEVOUT); P.ord.init(T, D, F.G, F.bx); P.bhalf_rows = 32;
            EpiBf16Plain E{(bf16*)(ws + WS_XN), D, 0, 0, 1.f, nullptr, 0, 1 << 30};
            pg8::gemm_phase(F.lds, P, E, F.tid);
        } break;
        CASE2(5, 14) {
            if (layer) router_mfma<true>(F, (const void*)(ws + WS_X1), (bf16*)(ws + WS_X1), KIN(12) + layer * D, (const bf16*)(ws + WS_WR) + (size_t)layer * 48 * 1024, KIN(14) + layer * 4, KIN(16) + layer * 32,
                        (const bf16*)(ws + WS_XN), (bf16*)(ws + WS_XN), (int*)(ws + WS_ROUTE), (float*)(ws + WS_ROUTE + 256 * 1024), (int*)(ws + WS_ROUTE + 512 * 1024), cnt, (int*)(ws + WS_LIST));
            else router_mfma<false>(F, (const void*)KIN(0), (bf16*)(ws + WS_X1), KIN(12) + layer * D, (const bf16*)(ws + WS_WR) + (size_t)layer * 48 * 1024, KIN(14) + layer * 4, KIN(16) + layer * 32,
                        (const bf16*)(ws + WS_XN), (bf16*)(ws + WS_XN), (int*)(ws + WS_ROUTE), (float*)(ws + WS_ROUTE + 256 * 1024), (int*)(ws + WS_ROUTE + 512 * 1024), cnt, (int*)(ws + WS_LIST));
        } break;
        CASE2(6, 15) {
            moe_tables(F.lds, cnt, F.tid);
            unsigned* ctlw = (unsigned*)(ws + WS_CTL);
            { ProbMoe1 P; P.K = 1024; P.A = (const char*)(ws + WS_XN); P.Wg = (const char*)(ws + WS_WG); P.Wu = (const char*)(ws + WS_WU); P.list = (const int*)(ws + WS_LIST);
              P.mt.tab = (LAS const int*)(F.lds + MOE_TAB_OFF); P.mt.head = ctlw + CW_QHEAD + ((layer * 2) * 2 + pass) * 64; P.mt.done = ctlw + CW_DONE + (layer * 2 + pass) * 256 * 64; P.mt.slot = (LAS int*)(F.lds + MOE_SLOT_OFF); P.mt.lane = F.lane;
              EpiMoe1 E{(bf16*)(ws + WS_H)};
              pg8::gemm_phase(F.lds, P, E, F.tid); }
            __syncthreads();
            { ProbMoe2 P; P.K = 512; P.A = (const char*)(ws + WS_H); P.Wd = (const char*)(ws + WS_WD);
              P.mt.tab = (LAS const int*)(F.lds + MOE_TAB_OFF); P.mt.head = ctlw + CW_QHEAD + ((layer * 2 + 1) * 2 + pass) * 64; P.mt.done = ctlw + CW_DONE + (layer * 2 + pass) * 256 * 64; P.mt.slot = (LAS int*)(F.lds + MOE_SLOT_OFF + 16); P.mt.lane = F.lane;
              EpiBf16Plain E{(bf16*)(ws + WS_Y), D, 0, 0, 1.f, nullptr, 0, 1 << 30};
              pg8::gemm_phase(F.lds, P, E, F.tid); }
        } break;
        CASE2(7, 16) { } break;
        CASE(8) {
            const int* eid = (const int*)(ws + WS_ROUTE); const float* gate = (const float*)(ws + WS_ROUTE + 256 * 1024); const int* rel = (const int*)(ws + WS_ROUTE + 512 * 1024);
            moe_tables(F.lds, cnt, F.tid);
            combine_gates_mfma(F, (bf16*)(ws + WS_X1), (const bf16*)(ws + WS_Y), eid, gate, rel, KIN(7), (bf16*)(ws + WS_XN), (const bf16*)(ws + WS_WGT), KIN(9), (float*)(ws + WS_GATES));
        } break;
        CASE(17) {
            const int* eid = (const int*)(ws + WS_ROUTE); const float* gate = (const float*)(ws + WS_ROUTE + 256 * 1024); const int* rel = (const int*)(ws + WS_ROUTE + 512 * 1024);
            moe_tables(F.lds, cnt, F.tid);
            final_combine(F, (const bf16*)(ws + WS_X1), (const bf16*)(ws + WS_Y), eid, gate, rel, KOUT());
        } break;
        CASE(9) {
            if ((F.vcu % MK_CONV_DIV) < MK_CONV_NUM) { const int cgw = ((F.vcu / MK_CONV_DIV) * MK_CONV_NUM + (F.vcu % MK_CONV_DIV)) * 8 + F.wave, cn = ((F.G / MK_CONV_DIV) * MK_CONV_NUM + min(F.G % MK_CONV_DIV, MK_CONV_NUM)) * 8;
                { const ConvSeg sg[3] = { {KIN(17) + (size_t)32 * 1024 * 512, (bf16*)(ws + WS_WG), 1024, 512, 512, 32, (size_t)1024 * 512, (size_t)512 * 1024},
                                          {KIN(18) + (size_t)32 * 1024 * 512, (bf16*)(ws + WS_WU), 1024, 512, 512, 32, (size_t)1024 * 512, (size_t)512 * 1024},
                                          {KIN(19) + (size_t)32 * 512 * 1024, (bf16*)(ws + WS_WD), 512, 1024, 1024, 32, (size_t)512 * 1024, (size_t)1024 * 512} };
                  convert_multi<3>(F, sg, cgw, cn); }
                __syncthreads(); }
            ProbDenseDyn P; P.K = 1024; P.A = (const char*)(ws + WS_XN); P.Bt = (const char*)(ws + WS_WODIN); P.ord.init(T, OD_INP, F.G, F.bx); P.bhalf_rows = 32;
            P.head = (unsigned*)(ws + WS_CTL) + CW_QDENSE + ((1 * 2 + pass) * 8) * 64; P.slot = (LAS int*)(F.lds + MOE_SLOT_OFF + 32); P.xlab = F.bx & 7;
            EpiBf16Plain E{(bf16*)(ws + WS_U), PQK, 2, 4, 0.125f, (bf16*)(ws + WS_U) + VO_OFF, PVO, 4};
            pg8::gemm_phase(F.lds, P, E, F.tid);
        } break;
        CASE(10) { float* SCg = (float*)(ws + WS_SC);
            m1_mfma(F, (const bf16*)(ws + WS_U), (const float*)(ws + WS_GATES), (bf16*)(ws + WS_DC), (float*)(ws + WS_DN), SCg, SCg + 4096); } break;
        CASE(11) { float* SCg = (float*)(ws + WS_SC);
            m2_phase(F, (const bf16*)(ws + WS_DC), (bf16*)(ws + WS_CP), (const float*)(ws + WS_DN), (float*)(ws + WS_NPREV), SCg, SCg + 4096, SCg + 8192); } break;
        CASE(12) { float* SCg = (float*)(ws + WS_SC);
            m3_mfma(F, (const bf16*)(ws + WS_U), (const float*)(ws + WS_GATES), (const bf16*)(ws + WS_CP), (const float*)(ws + WS_NPREV), SCg + 8192, KIN(10), (bf16*)(ws + WS_Y2)); } break;
        CASE(13) {
            ProbDense P; P.K = 1024; P.A = (const char*)(ws + WS_Y2); P.Bt = (const char*)(ws + WS_WODOUT); P.ord.init(T, D, F.G, F.bx); P.bhalf_rows = 32;
            EpiBf16Plain E{(bf16*)(ws + WS_XN), D, 0, 0, 1.f, nullptr, 0, 1 << 30};
            pg8::gemm_phase(F.lds, P, E, F.tid);
        } break;
        default: break;
        }
        if (step + 1 < nsteps && ph != 6 && ph != 15) { XcdBarrier bar; bar.bar = (unsigned*)(KWS() + WS_CTL) + CW_BAR; bar.x = xb_xcc_id(); bar.st = (volatile LAS unsigned*)((LAS unsigned char*)lds_raw + MISC_OFF) + 8; xcd_barrier(bar); }
        if (PROBE_REP) { if (((PROBE_REP >> ph) & 1u) && !redo) { redo = 1; --step; } else redo = 0; }
    }
#undef CASE
#undef CASE2
}

extern "C" void kernel_launch(void* const* d_in, const int* in_sizes, int n_in, void* d_out, int out_size, void* d_ws, size_t ws_size, hipStream_t stream) {
    static int grid = 0;
    if (grid == 0) {
        if (n_in != 20 || in_sizes[0] != T * D || out_size != T * D || ws_size < WS_END) { fprintf(stderr, "kernel_launch: unexpected shapes (n_in %d, in0 %d, out %d, ws %zu < %zu)\n", n_in, n_in > 0 ? in_sizes[0] : -1, out_size, ws_size, (size_t)WS_END); grid = -1; return; }
        int dev = 0, cus = 0, per_cu = 0;
        if (hipGetDevice(&dev) != hipSuccess || hipDeviceGetAttribute(&cus, hipDeviceAttributeMultiprocessorCount, dev) != hipSuccess) { grid = -1; return; }
        if (hipFuncSetAttribute((const void*)mk_fwd, hipFuncAttributeMaxDynamicSharedMemorySize, LDS_BYTES) != hipSuccess) { fprintf(stderr, "kernel_launch: hipFuncSetAttribute failed\n"); grid = -1; return; }
        if (hipOccupancyMaxActiveBlocksPerMultiprocessor(&per_cu, (const void*)mk_fwd, 512, LDS_BYTES) != hipSuccess || per_cu < 1) { fprintf(stderr, "kernel_launch: occupancy query reports %d\n", per_cu); }
        (void)hipGetLastError();
        grid = cus;
    }
    if (grid < 0) return;
    if (hipMemsetAsync((char*)d_ws + WS_CTL, 0, CTL_ZERO_BYTES, stream) != hipSuccess) return;
    Args a{};
    for (int i = 0; i < 20; ++i) a.in[i] = (const float*)d_in[i];
    a.out = (float*)d_out; a.ws = (unsigned char*)d_ws;
#if MK_PER_PHASE
    for (int p = 0; p < NPH; ++p) { a.ph_lo = p; a.ph_hi = p + 1; hipLaunchKernelGGL(mk_fwd, dim3(grid), dim3(512), LDS_BYTES, stream, a); }
#else
    a.ph_lo = 0; a.ph_hi = NPH;
    hipLaunchKernelGGL(mk_fwd, dim3(grid), dim3(512), LDS_BYTES, stream, a);
#endif
}
```

```cpp
#include <hip/hip_runtime.h>
#include <cstdio>
#include <cstdint>

#define GAS __attribute__((address_space(1)))
#define LAS __attribute__((address_space(3)))
typedef unsigned short bf16;
typedef unsigned v4u __attribute__((ext_vector_type(4)));
typedef unsigned v2u __attribute__((ext_vector_type(2)));
typedef float f32x4 __attribute__((ext_vector_type(4)));
typedef float f32x2 __attribute__((ext_vector_type(2)));
typedef short bf16x8 __attribute__((ext_vector_type(8)));
typedef GAS unsigned gu32;

#ifndef PROBE_REP
#define PROBE_REP 0u
#endif
#ifndef MK_PER_PHASE
#define MK_PER_PHASE 0
#endif

constexpr int NB = 4, SEQ = 4096, T = NB * SEQ, D = 1024;
constexpr int EV_IN = 2048, OD_IN = 3104, OD_INP = 3072;
constexpr int PU = EV_IN + 32;
constexpr int NE = 32, FF = 512;
constexpr int PQK = 1024 + 32, PVO = 2048 + 32;
constexpr size_t VO_OFF = (size_t)T * PQK;
constexpr float RMS_EPS = 1e-6f;
constexpr int NPH = 18;

constexpr size_t MiB = 1u << 20;
constexpr size_t WS_CTL = 0, CTL_ZERO_BYTES = 1 * MiB;
constexpr size_t WS_WEVIN = 1 * MiB, WS_WEVOUT = 5 * MiB, WS_WODIN = 7 * MiB, WS_WODOUT = 13 * MiB;
constexpr size_t WS_ROUTE = 15 * MiB;
constexpr size_t WS_GATES = 16 * MiB;
constexpr size_t WS_LIST = 18 * MiB;
constexpr size_t WS_SC = 20 * MiB;
constexpr size_t WS_WR = 20 * MiB + 512 * 1024;
constexpr size_t WS_WGT = WS_WR + 2 * 48 * 1024 * 2;
constexpr size_t WS_DN = 21 * MiB, WS_NPREV = 22 * MiB;
constexpr size_t WS_WG = 24 * MiB, WS_WU = 56 * MiB, WS_WD = 88 * MiB;
constexpr size_t WS_XN = 120 * MiB;
constexpr size_t WS_X1 = 153 * MiB;
constexpr size_t WS_U = 217 * MiB;
constexpr size_t WS_MIX = 313 * MiB;
constexpr size_t WS_Y = 217 * MiB;
constexpr size_t WS_H = 297 * MiB;
constexpr size_t WS_DC = 345 * MiB;
constexpr size_t WS_CP = 409 * MiB;
constexpr size_t WS_Y2 = 474 * MiB;
constexpr size_t WS_END = 508 * MiB;

constexpr int CW_BAR = 4096;
constexpr int CW_CNT = 16384;
constexpr int CW_QHEAD = 40960;
constexpr int CW_QDENSE = 45056;
constexpr int CW_DONE = 49152;

constexpr int RING_BYTES = 131072, LDSCTL_OFF = RING_BYTES, MISC_OFF = LDSCTL_OFF + 320, LDS_BYTES = 147456;

#define RLX_AGENT __ATOMIC_RELAXED, __HIP_MEMORY_SCOPE_AGENT
#define LDS_WAIT() asm volatile("s_waitcnt lgkmcnt(0)" ::: "memory")
#define VM_WAIT() asm volatile("s_waitcnt vmcnt(0)" ::: "memory")

__device__ __forceinline__ unsigned f2bf(float f) { unsigned u = __builtin_bit_cast(unsigned, f); return (u + 0x7fffu + ((u >> 16) & 1u)) >> 16; }
__device__ __forceinline__ unsigned pk2(float lo, float hi) { return f2bf(lo) | (f2bf(hi) << 16); }
__device__ __forceinline__ float bf2f(unsigned short b) { return __builtin_bit_cast(float, ((unsigned)b) << 16); }
__device__ __forceinline__ float bflo(unsigned w) { return __builtin_bit_cast(float, w << 16); }
__device__ __forceinline__ float bfhi(unsigned w) { return __builtin_bit_cast(float, w & 0xffff0000u); }
__device__ __forceinline__ float shf(float v, int src) { return __builtin_bit_cast(float, __builtin_amdgcn_ds_bpermute(src << 2, __builtin_bit_cast(int, v))); }
__device__ __forceinline__ int shfi(int v, int src) { return __builtin_amdgcn_ds_bpermute(src << 2, v); }
__device__ __forceinline__ float shx(float v, int mask, int lane) { return shf(v, lane ^ mask); }
__device__ __forceinline__ float shup(float v, int d, int lane) { return shf(v, lane >= d ? lane - d : lane); }
#define MK_DPPF(idv, x, ctrl, rmask) __builtin_bit_cast(float, __builtin_amdgcn_update_dpp(__builtin_bit_cast(int, (float)(idv)), __builtin_bit_cast(int, (float)(x)), (ctrl), (rmask), 0xF, false))
__device__ __forceinline__ float dpp_scan_add(float x) {
    x += MK_DPPF(0.f, x, 0x111, 0xF); x += MK_DPPF(0.f, x, 0x112, 0xF); x += MK_DPPF(0.f, x, 0x114, 0xF); x += MK_DPPF(0.f, x, 0x118, 0xF);
    x += MK_DPPF(0.f, x, 0x142, 0xA); x += MK_DPPF(0.f, x, 0x143, 0xC); return x; }
__device__ __forceinline__ float dpp_scan_max(float x) {
    x = fmaxf(x, MK_DPPF(-3.0e38f, x, 0x111, 0xF)); x = fmaxf(x, MK_DPPF(-3.0e38f, x, 0x112, 0xF)); x = fmaxf(x, MK_DPPF(-3.0e38f, x, 0x114, 0xF)); x = fmaxf(x, MK_DPPF(-3.0e38f, x, 0x118, 0xF));
    x = fmaxf(x, MK_DPPF(-3.0e38f, x, 0x142, 0xA)); x = fmaxf(x, MK_DPPF(-3.0e38f, x, 0x143, 0xC)); return x; }
__device__ __forceinline__ float lane63(float x) { return __builtin_bit_cast(float, __builtin_amdgcn_readlane(__builtin_bit_cast(int, x), 63)); }
__device__ __forceinline__ int shupi(int v, int d, int lane) { return shfi(v, lane >= d ? lane - d : lane); }
__device__ __forceinline__ float wave_sum(float v, int lane) {
#pragma unroll
    for (int o = 1; o < 64; o <<= 1) v += shx(v, o, lane);
    return v;
}
__device__ __forceinline__ float wave_max(float v, int lane) {
#pragma unroll
    for (int o = 1; o < 64; o <<= 1) v = fmaxf(v, shx(v, o, lane));
    return v;
}
__device__ __forceinline__ float log_sigmoid(float x) { return fminf(x, 0.f) - __logf(1.f + __expf(-fabsf(x))); }

#define XB_TMO      128
#define XB_XCNT(j)  (256  + 64 * (j))
#define XB_XSUB(j)  (1280 + 64 * (j))
#define XB_XGEN(j)  (2304 + 64 * (j))
#define XB_TOP      3328
#define XB_TOPGEN   3392
#define XCD_BAR_WORDS 3456
#define XB_SPIN_CAP (1u << 18)
__device__ __forceinline__ unsigned xb_ld(unsigned* p)              { return __hip_atomic_load(p, __ATOMIC_RELAXED, __HIP_MEMORY_SCOPE_AGENT); }
__device__ __forceinline__ unsigned xb_add(unsigned* p, unsigned v) { return __hip_atomic_fetch_add(p, v, __ATOMIC_RELAXED, __HIP_MEMORY_SCOPE_AGENT); }
__device__ __forceinline__ unsigned xb_xcc_id() { return (unsigned)__builtin_amdgcn_s_getreg((3 << 11) | 20) & 0xFu; }
#define XB_SPIN(cond, bar) do { unsigned _sp = 0; while (cond) { __builtin_amdgcn_s_sleep(1); \
    if ((++_sp & 255u) == 0u) { if (xb_ld(&(bar)[XB_TMO])) break; if (_sp > XB_SPIN_CAP) { atomicAdd(&(bar)[XB_TMO], 1u); break; } } } } while (0)
struct XcdBarrier { unsigned* bar; unsigned x; volatile LAS unsigned* st; };
__device__ __forceinline__ XcdBarrier xcd_barrier_post(unsigned* bar, volatile LAS unsigned* st) {
    XcdBarrier b; b.bar = bar; b.x = xb_xcc_id(); b.st = st;
    if (threadIdx.x == 0) (void)xb_add(&bar[XB_XCNT(b.x)], 1u);
    return b;
}
__device__ __forceinline__ void xcd_barrier_complete(unsigned* bar, unsigned x, unsigned& nloc, unsigned& nx) {
    const unsigned G = gridDim.x * gridDim.y * gridDim.z;
    unsigned sum, cnt, mine, sp = 0u;
    for (;;) {
        sum = 0u; cnt = 0u; mine = 0u;
#pragma unroll
        for (unsigned j = 0; j < 16; ++j) { const unsigned c = xb_ld(&bar[XB_XCNT(j)]); sum += c; cnt += (c > 0u) ? 1u : 0u; mine = (j == x) ? c : mine; }
        if (sum == G) break;
        __builtin_amdgcn_s_sleep(1);
        if ((++sp & 255u) == 0u) { if (xb_ld(&bar[XB_TMO])) break; if (sp > XB_SPIN_CAP) { atomicAdd(&bar[XB_TMO], 1u); break; } }
    }
    nloc = mine > 0u ? mine : 1u; nx = cnt > 0u ? cnt : 1u;
}
__device__ __forceinline__ void xcd_barrier(const XcdBarrier& b) {
    asm volatile("s_waitcnt vmcnt(0)" ::: "memory");
    __syncthreads();
    if (threadIdx.x == 0) {
        unsigned* bar = b.bar;
        __builtin_amdgcn_s_waitcnt(0);
        unsigned nloc = b.st[0], nx = b.st[1];
        if (nloc == 0u) { xcd_barrier_complete(bar, b.x, nloc, nx); b.st[0] = nloc; b.st[1] = nx; }
        const unsigned old = xb_add(&bar[XB_XSUB(b.x)], 1u);
        const unsigned gen = old / nloc;
        if (old + 1u == (gen + 1u) * nloc) {
            __builtin_amdgcn_fence(__ATOMIC_RELEASE, "agent");
            asm volatile("s_waitcnt vmcnt(0)" ::: "memory");
            const unsigned og = xb_add(&bar[XB_TOP], 1u);
            const unsigned tg = og / nx;
            if (og + 1u == (tg + 1u) * nx) xb_add(&bar[XB_TOPGEN], 1u);
            else XB_SPIN(xb_ld(&bar[XB_TOPGEN]) == tg, bar);
            __builtin_amdgcn_fence(__ATOMIC_ACQUIRE, "agent");
            xb_add(&bar[XB_XGEN(b.x)], 1u);
            asm volatile("s_waitcnt vmcnt(0)" ::: "memory");
        } else {
            XB_SPIN(xb_ld(&bar[XB_XGEN(b.x)]) == gen, bar);
            __builtin_amdgcn_fence(__ATOMIC_ACQUIRE, "agent");
            asm volatile("s_waitcnt vmcnt(0)" ::: "memory");
        }
    }
    __syncthreads();
}

namespace pg8 {
constexpr int RS_TAB_OFF = 131072 + 4096 + 8192;
constexpr int NA_SLOT_OFF = 131072 + 4096;
constexpr int BM = 256, BK = 64, HALF = 128, HTB = HALF * BK * 2, NXCD = 8, WGM = 8;
__device__ __forceinline__ int lds_byte(int r, int c) { const int st = (r >> 4) * 2 + (c >> 5), rr = r & 15, cc = c & 31, ob = rr * 64 + cc * 2; return st * 1024 + (ob ^ (((ob >> 9) & 1) << 5)); }
__device__ __forceinline__ void stage_rc(int b, int& R, int& C) { const int st = b / 1024, sb = b % 1024, swz = sb ^ (((sb >> 9) & 1) << 5); R = (st >> 1) * 16 + swz / 64; C = (st & 1) * 32 + (swz % 64) / 2; }
__device__ __forceinline__ int perm32(int rho) { const int n = rho >> 4, i = rho & 15; return 8 * (i >> 2) + 4 * n + (i & 3); }
typedef __bf16 bf16x2_t __attribute__((ext_vector_type(2)));
__device__ __forceinline__ unsigned cvt_pk_bf16(float lo, float hi) { const f32x2 v = {lo, hi}; return __builtin_bit_cast(unsigned, __builtin_convertvector(v, bf16x2_t)); }

struct Unit { int pm, pn; };
struct UnitM { int pm, pn, e, cnt, rb, par; };

struct DenseOrder {
    int nM, nN, nwg, G, c;
    __device__ void init(int M, int N, int G_, int c_) { nM = M / BM; nN = N / BM; nwg = nM * nN; G = G_; c = c_; }
    __device__ bool next(int i, Unit& u) const { return at((long)i * G + c, u); }
    __device__ bool at(long L, Unit& u) const {
        if (L < 0 || L >= nwg) return false;
        int wgid = (int)L; { const int q = nwg / NXCD, r = nwg % NXCD, xcd = wgid % NXCD, off = wgid / NXCD; wgid = (xcd < r ? xcd * (q + 1) : r * (q + 1) + (xcd - r) * q) + off; }
        const int nig = WGM * nN, gid = wgid / nig, fm = gid * WGM, gsz = (nM - fm) < WGM ? (nM - fm) : WGM;
        u.pm = fm + ((wgid % nig) % gsz); u.pn = (wgid % nig) / gsz; return true;
    }
};

#define PG8_SA(b, h) (((b) * 2 + (h)) * HTB)
#define PG8_SB(b, h) ((4 + (b) * 2 + (h)) * HTB)
#define PG8_STAGE(bufoff, gbase, v0, v1) do { \
        __builtin_amdgcn_global_load_lds((const unsigned*)((const char*)(gbase) + (v0)), (LAS unsigned*)(lds + (bufoff) + ldsw), 16, 0, 0); \
        __builtin_amdgcn_global_load_lds((const unsigned*)((const char*)(gbase) + (v1)), (LAS unsigned*)(lds + (bufoff) + ldsw + 8192), 16, 0, 0); } while (0)
#define PG8_LDA(dst, b, h) do { _Pragma("unroll") for (int m = 0; m < 4; ++m) _Pragma("unroll") for (int k = 0; k < 2; ++k) dst[m][k] = *(const LAS bf16x8*)(lds + PG8_SA(b, h) + aoff + m * 2048 + k * 1024); } while (0)
#define PG8_LDB(dst, b, h) do { _Pragma("unroll") for (int n = 0; n < 2; ++n) _Pragma("unroll") for (int k = 0; k < 2; ++k) dst[n][k] = *(const LAS bf16x8*)(lds + PG8_SB(b, h) + boff + n * 2048 + k * 1024); } while (0)
#define PG8_MMA(ai, bj, At, Bt) do { __builtin_amdgcn_s_setprio(1); _Pragma("unroll") for (int m = 0; m < 4; ++m) _Pragma("unroll") for (int n = 0; n < 2; ++n) _Pragma("unroll") for (int k = 0; k < 2; ++k) \
        acc[ai][bj][m][n] = __builtin_amdgcn_mfma_f32_16x16x32_bf16(Bt[n][k], At[m][k], acc[ai][bj][m][n], 0, 0, 0); __builtin_amdgcn_s_setprio(0); } while (0)
#define PG8_WAIT_V(n) asm volatile("s_waitcnt vmcnt(" #n ")" ::: "memory")
#define PG8_WAIT_L(n) asm volatile("s_waitcnt lgkmcnt(" #n ")" ::: "memory")
#define PG8_BAR __builtin_amdgcn_s_barrier()
#define PG8_SCHED __builtin_amdgcn_sched_barrier(0)

template <class Epi, class Prob>
__device__ __forceinline__ void gemm_phase(LAS unsigned char* lds, const Prob& P, const Epi& E, const int tid) {
    typedef typename Prob::Unit Unit;
    constexpr bool GA = Prob::GATHER;
#ifndef MK_ALIGN_EPI
#define MK_ALIGN_EPI 1
#endif
    constexpr bool ALIGN_EPI = MK_ALIGN_EPI;
    const int wid = __builtin_amdgcn_readfirstlane(tid >> 6), lane = tid & 63, wr = wid >> 2, wc = wid & 3, fr = lane & 15, fq = lane >> 4;
    const int K = P.K, nt = K / BK;
    unsigned vb0, vb1;
    unsigned va00, va01, va10, va11;
    { int R0, C0, R1, C1; stage_rc(tid * 16, R0, C0); stage_rc(tid * 16 + 8192, R1, C1);
      vb0 = (unsigned)(Epi::brow(R0) * K + C0) * 2u; vb1 = (unsigned)(Epi::brow(R1) * K + C1) * 2u; }
    const unsigned ldsw = (unsigned)wid * 1024u;
    const int aoff = lds_byte(wr * 64 + fr, fq * 8), boff = lds_byte(wc * 32 + fr, fq * 8);
    Unit cur, nxt; int ui = 0;
    if (!P.first(cur, tid)) return;
    f32x4 acc[2][2][4][2];
#pragma unroll
    for (int a = 0; a < 2; ++a)
#pragma unroll
        for (int b = 0; b < 2; ++b)
#pragma unroll
            for (int m = 0; m < 4; ++m)
#pragma unroll
                for (int n = 0; n < 2; ++n) acc[a][b][m][n] = (f32x4){0.f, 0.f, 0.f, 0.f};
    bf16x8 At[4][2], B0[2][2], B1[2][2];
    { int R0, C0, R1, C1; stage_rc(tid * 16, R0, C0); stage_rc(tid * 16 + 8192, R1, C1);
      va00 = P.a_off(cur, 0, R0, C0); va01 = P.a_off(cur, 0, R1, C1);
      if (GA) { va10 = P.a_off(cur, 1, R0, C0); va11 = P.a_off(cur, 1, R1, C1); } else { va10 = va00; va11 = va01; } }
    if constexpr (GA) { cur.par = 0; P.park_store(cur, tid, lds, P.park_load(cur, tid)); }
    const char* cA0 = P.a_ptr(cur, 0); const char* cA1 = P.a_ptr(cur, 1); const char* cB0 = P.b_ptr(cur, 0); const char* cB1 = P.b_ptr(cur, 1);
    const size_t kstep = (size_t)(BK * 2);
    P.a_ready(cur, tid);
    PG8_STAGE(PG8_SB(0, 0), cB0, vb0, vb1); PG8_STAGE(PG8_SB(0, 1), cB1, vb0, vb1); PG8_STAGE(PG8_SA(0, 0), cA0, va00, va01); PG8_STAGE(PG8_SA(0, 1), cA1, va10, va11);
    if (wr == 1) PG8_BAR;
    PG8_WAIT_V(2); PG8_BAR;
    PG8_STAGE(PG8_SB(1, 0), cB0 + kstep, vb0, vb1); PG8_STAGE(PG8_SA(1, 0), cA0 + kstep, va00, va01); PG8_STAGE(PG8_SB(1, 1), cB1 + kstep, vb0, vb1);
    PG8_WAIT_V(6); PG8_BAR;
    for (;;) {
        const int req = P.request(ui + 1, tid);
        bool has_next = false;
        const char* nA0 = cA0; const char* nA1 = cA1; const char* nB0 = cB0; const char* nB1 = cB1;
        for (int t = 0; t < nt; t += 2) {
            const bool last = (t == nt - 2);
            if (t == nt - 4) P.post(ui + 1, tid, req);
            if (last) { has_next = P.fetch(ui + 1, nxt);
                if (has_next) { nA0 = P.a_ptr(nxt, 0); nA1 = P.a_ptr(nxt, 1); nB0 = P.b_ptr(nxt, 0); nB1 = P.b_ptr(nxt, 1); P.a_ready(nxt, tid);
                    float pv = 0.f; if constexpr (GA) { nxt.par = (ui + 1) & 1; pv = P.park_load(nxt, tid); }
                    if (GA) { int R0, C0, R1, C1; stage_rc(tid * 16, R0, C0); stage_rc(tid * 16 + 8192, R1, C1);
                        v4u nv; nv.x = P.a_off(nxt, 0, R0, C0); nv.y = P.a_off(nxt, 0, R1, C1); nv.z = P.a_off(nxt, 1, R0, C0); nv.w = P.a_off(nxt, 1, R1, C1);
                        *(LAS v4u*)(lds + NA_SLOT_OFF + tid * 16) = nv; }
                    if constexpr (GA) P.park_store(nxt, tid, lds, pv); } }
            const char* a11 = cA1 + (size_t)(t + 1) * kstep;
            const char* a20 = last ? nA0 : cA0 + (size_t)(t + 2) * kstep; const char* a21 = last ? nA1 : cA1 + (size_t)(t + 2) * kstep;
            const char* b20 = last ? nB0 : cB0 + (size_t)(t + 2) * kstep; const char* b21 = last ? nB1 : cB1 + (size_t)(t + 2) * kstep;
            PG8_LDB(B0, 0, 0); PG8_LDB(B1, 0, 1); PG8_SCHED; PG8_LDA(At, 0, 0); PG8_STAGE(PG8_SA(1, 1), a11, va10, va11);
            if (GA) { if (last && has_next) { const v4u nv = *(const LAS v4u*)(lds + NA_SLOT_OFF + tid * 16); va00 = nv.x; va01 = nv.y; va10 = nv.z; va11 = nv.w; } }
            PG8_WAIT_V(8); PG8_WAIT_L(0); PG8_BAR; PG8_MMA(0, 0, At, B0); PG8_MMA(0, 1, At, B1); PG8_BAR; PG8_SCHED;
            PG8_LDA(At, 0, 1); PG8_STAGE(PG8_SB(0, 0), b20, vb0, vb1); PG8_STAGE(PG8_SB(0, 1), b21, vb0, vb1); PG8_STAGE(PG8_SA(0, 0), a20, va00, va01);
            PG8_WAIT_V(8); PG8_WAIT_L(0); PG8_BAR; PG8_MMA(1, 0, At, B0); PG8_MMA(1, 1, At, B1); PG8_BAR; PG8_SCHED;
            PG8_LDB(B0, 1, 0); PG8_LDB(B1, 1, 1); PG8_SCHED; PG8_LDA(At, 1, 0); PG8_STAGE(PG8_SA(0, 1), a21, va10, va11);
            PG8_WAIT_V(8); PG8_WAIT_L(0); PG8_BAR; PG8_MMA(0, 0, At, B0); PG8_MMA(0, 1, At, B1); PG8_BAR; PG8_SCHED;
            PG8_LDA(At, 1, 1); PG8_STAGE(PG8_SB(1, 0), b20 + kstep, vb0, vb1); PG8_STAGE(PG8_SB(1, 1), b21 + kstep, vb0, vb1); PG8_STAGE(PG8_SA(1, 0), a20 + kstep, va00, va01);
            PG8_WAIT_V(8); PG8_WAIT_L(0); PG8_BAR; PG8_MMA(1, 0, At, B0); PG8_MMA(1, 1, At, B1); PG8_BAR; PG8_SCHED;
        }
        if (ALIGN_EPI) { if (wr == 0) PG8_BAR; }
        E(acc, cur, wr, wc, fr, fq);
        P.done(cur, lane);
        if (!has_next) break;
#pragma unroll
        for (int a = 0; a < 2; ++a)
#pragma unroll
            for (int b = 0; b < 2; ++b)
#pragma unroll
                for (int m = 0; m < 4; ++m)
#pragma unroll
                    for (int n = 0; n < 2; ++n) acc[a][b][m][n] = (f32x4){0.f, 0.f, 0.f, 0.f};
        cur = nxt; cA0 = nA0; cA1 = nA1; cB0 = nB0; cB1 = nB1; ++ui;
        if (ALIGN_EPI) { if (wr == 1) PG8_BAR; }
    }
    PG8_WAIT_V(0);
    if (!ALIGN_EPI) { if (wr == 0) PG8_BAR; }
    PG8_BAR;
}
}

struct ProbDense {
    typedef pg8::Unit Unit;
    static constexpr bool GATHER = false;
    int K; const char* A; const char* Bt; pg8::DenseOrder ord; int bhalf_rows;
    __device__ __forceinline__ bool first(Unit& u, int) const { return ord.next(0, u); }
    __device__ __forceinline__ int request(int, int) const { return 0; }
    __device__ __forceinline__ void post(int, int, int) const {}
    __device__ __forceinline__ bool fetch(int i, Unit& u) const { return ord.next(i, u); }
    __device__ __forceinline__ void a_ready(const Unit&, int) const {}
    __device__ __forceinline__ void done(const Unit&, int) const {}
    __device__ __forceinline__ const char* a_ptr(const Unit& u, int h) const { return A + (size_t)(u.pm * 256 + h * 128) * K * 2; }
    __device__ __forceinline__ unsigned a_off(const Unit& u, int h, int R, int C) const { return (unsigned)(R * K + C) * 2u; }
    __device__ __forceinline__ const char* b_ptr(const Unit& u, int h) const { return Bt + ((size_t)(u.pn * 256 + h * bhalf_rows) * K) * 2; }
};
struct ProbDenseDyn {
    typedef pg8::Unit Unit;
    static constexpr bool GATHER = false;
    int K; const char* A; const char* Bt; pg8::DenseOrder ord; int bhalf_rows; unsigned* head; LAS int* slot; int xlab;
    __device__ __forceinline__ int pull() const {
        int res = -1;
#pragma unroll 1
        for (int k = 0; k < 8; ++k) { const int x = (xlab + k) & 7; const int q = __builtin_amdgcn_readfirstlane((int)__hip_atomic_fetch_add(head + 64 * x, 1u, RLX_AGENT));
            if (8 * q + x < ord.nwg) { res = 8 * q + x; break; } }
        return res; }
    __device__ __forceinline__ bool first(Unit& u, int tid) const { if (tid == 0) slot[0] = pull(); __syncthreads(); return ord.at(__builtin_amdgcn_readfirstlane(slot[0]), u); }
    __device__ __forceinline__ int request(int, int tid) const { int r = 0; if (tid == 0) r = pull(); return r; }
    __device__ __forceinline__ void post(int i, int tid, int r) const { if (tid == 0) slot[i & 1] = r; }
    __device__ __forceinline__ bool fetch(int i, Unit& u) const { return ord.at(__builtin_amdgcn_readfirstlane(slot[i & 1]), u); }
    __device__ __forceinline__ void a_ready(const Unit&, int) const {}
    __device__ __forceinline__ void done(const Unit&, int) const {}
    __device__ __forceinline__ const char* a_ptr(const Unit& u, int h) const { return A + (size_t)(u.pm * 256 + h * 128) * K * 2; }
    __device__ __forceinline__ unsigned a_off(const Unit& u, int h, int R, int C) const { return (unsigned)(R * K + C) * 2u; }
    __device__ __forceinline__ const char* b_ptr(const Unit& u, int h) const { return Bt + ((size_t)(u.pn * 256 + h * bhalf_rows) * K) * 2; }
};
constexpr int MOE_TAB_OFF = LDSCTL_OFF + 1024;
__device__ __forceinline__ void moe_tables(LAS unsigned char* lds, const unsigned* cnt, int tid) {
    LAS int* tab = (LAS int*)(lds + MOE_TAB_OFF);
    if (tid < 64) { const int n = (tid < NE) ? (int)__hip_atomic_load(cnt + 64 * (tid & 31), RLX_AGENT) : 0; int x = (n + 255) >> 8;
#pragma unroll
        for (int o = 1; o < 64; o <<= 1) { const int y = shupi(x, o, tid); if (tid >= o) x += y; }
        if (tid < NE) { tab[tid + 1] = x; tab[40 + tid] = n; } if (tid == 0) tab[0] = 0; }
    __syncthreads();
}
constexpr int MOE_SLOT_OFF = MOE_TAB_OFF + 512;
struct MoeTiles {
    LAS const int* tab; unsigned* head; unsigned* done; LAS int* slot; int lane;
    __device__ __forceinline__ bool unit(int L, pg8::UnitM& u) const {
        const int tile = L >> 2;
        const int tpl = tab[lane & 31];
        const unsigned long long m = __ballot(lane < 32 && tpl <= tile);
        const int e = __builtin_amdgcn_readfirstlane(__popcll(m) - 1);
        const int total = __builtin_amdgcn_readfirstlane(tab[32]);
        if (tile >= total) return false;
        const int tp = __builtin_amdgcn_readfirstlane(tab[e]), n = __builtin_amdgcn_readfirstlane(tab[40 + e]);
        u.e = e; u.rb = (tile - tp) * 256; u.cnt = n - u.rb; u.pm = tile; u.pn = L & 3; return true;
    }
    __device__ __forceinline__ bool first(pg8::UnitM& u, int tid) const {
        if (tid == 0) slot[0] = (int)__hip_atomic_fetch_add(head, 1u, RLX_AGENT);
        __syncthreads();
        return unit(__builtin_amdgcn_readfirstlane(slot[0]), u); }
    __device__ __forceinline__ int request(int i, int tid) const { int r = 0; if (tid == 0) r = (int)__hip_atomic_fetch_add(head, 1u, RLX_AGENT); return r; }
    __device__ __forceinline__ void post(int i, int tid, int r) const { if (tid == 0) slot[i & 1] = r; }
    __device__ __forceinline__ bool fetch(int i, pg8::UnitM& u) const { return unit(__builtin_amdgcn_readfirstlane(slot[i & 1]), u); }
    __device__ __forceinline__ void publish(const pg8::UnitM& u, int lane_) const {
        asm volatile("s_waitcnt vmcnt(0)" ::: "memory");
        if (lane_ == 0) (void)__hip_atomic_fetch_add(done + 64 * u.pm, 1u, RLX_AGENT); }
    __device__ __forceinline__ void wait_tile(const pg8::UnitM& u, int tid) const {
        if (tid < 64) { unsigned polls = 0;
            while ((unsigned)__builtin_amdgcn_readfirstlane((int)__hip_atomic_load(done + 64 * u.pm, RLX_AGENT)) < 32u) { __builtin_amdgcn_s_sleep(2); if (++polls > (1u << 21)) break; }
            __builtin_amdgcn_fence(__ATOMIC_ACQUIRE, "agent");
            asm volatile("s_waitcnt vmcnt(0)" ::: "memory"); }
        asm volatile("" ::: "memory"); __builtin_amdgcn_s_barrier(); asm volatile("" ::: "memory"); }
};
struct ProbMoe1 {
    typedef pg8::UnitM Unit;
    static constexpr bool GATHER = true;
    int K; const char* A; const char* Wg; const char* Wu; const int* list; MoeTiles mt;
    __device__ __forceinline__ bool first(Unit& u, int tid) const { return mt.first(u, tid); }
    __device__ __forceinline__ int request(int i, int tid) const { return mt.request(i, tid); }
    __device__ __forceinline__ void post(int i, int tid, int r) const { mt.post(i, tid, r); }
    __device__ __forceinline__ bool fetch(int i, Unit& u) const { return mt.fetch(i, u); }
    __device__ __forceinline__ void a_ready(const Unit&, int) const {}
    __device__ __forceinline__ void done(const Unit& u, int lane_) const { mt.publish(u, lane_); }
    __device__ __forceinline__ const char* a_ptr(const Unit& u, int h) const { return A; }
    __device__ __forceinline__ unsigned a_off(const Unit& u, int h, int R, int C) const {
        const int r = h * 128 + R;
        const int tl = ((const GAS int*)list)[u.e * 16384 + u.rb + min(r, max(u.cnt, 1) - 1)];
        const int tok = (r < u.cnt) ? tl : T;
        return (unsigned)(tok * 1024 + C) * 2u; }
    __device__ __forceinline__ const char* b_ptr(const Unit& u, int h) const { return (h ? Wu : Wg) + ((size_t)u.e * 512 * 1024 + (size_t)u.pn * 128 * 1024) * 2; }
    const float* RSs;
    __device__ __forceinline__ float park_load(const Unit& u, int tid) const { const int r = tid & 255; return ((const GAS float*)RSs)[u.e * 16384 + u.rb + min(r, max(u.cnt, 1) - 1)]; }
    __device__ __forceinline__ void park_store(const Unit& u, int tid, LAS unsigned char* lds, float v) const { const int r = tid & 255; ((LAS float*)(lds + pg8::RS_TAB_OFF))[u.par * 256 + r] = (r < u.cnt) ? v : 0.f; }
};
struct ProbMoe2 {
    typedef pg8::UnitM Unit;
    static constexpr bool GATHER = false;
    int K; const char* A; const char* Wd; MoeTiles mt;
    __device__ __forceinline__ bool first(Unit& u, int tid) const { return mt.first(u, tid); }
    __device__ __forceinline__ int request(int i, int tid) const { return mt.request(i, tid); }
    __device__ __forceinline__ void post(int i, int tid, int r) const { mt.post(i, tid, r); }
    __device__ __forceinline__ bool fetch(int i, Unit& u) const { return mt.fetch(i, u); }
    __device__ __forceinline__ void a_ready(const Unit& u, int tid) const { mt.wait_tile(u, tid); }
    __device__ __forceinline__ void done(const Unit&, int) const {}
    __device__ __forceinline__ const char* a_ptr(const Unit& u, int h) const { return A + (size_t)(u.pm * 256 + h * 128) * 512 * 2; }
    __device__ __forceinline__ unsigned a_off(const Unit& u, int h, int R, int C) const { return (unsigned)(R * 512 + C) * 2u; }
    __device__ __forceinline__ const char* b_ptr(const Unit& u, int h) const { return Wd + ((size_t)u.e * 1024 * 512 + (size_t)(u.pn * 256 + h * 32) * 512) * 2; }
};

struct EpiBf16Plain {
    bf16* O; int ldc; int sc_lo, sc_hi; float scale; bf16* O2; int ldc2, split_pn;
    const float* RS = nullptr;
    static __device__ __forceinline__ int brow(int rho) { return 64 * (rho >> 5) + pg8::perm32(rho & 31); }
    template <class UnitT> __device__ __forceinline__ void operator()(const f32x4 (&acc)[2][2][4][2], const UnitT& u, int wr, int wc, int fr, int fq) const {
        const bool second = u.pn >= split_pn; bf16* const Ob = second ? O2 : O; const int ld = second ? ldc2 : ldc;
        const int row0 = u.pm * 256 + wr * 64 + fr, col0 = (second ? u.pn - split_pn : u.pn) * 256 + wc * 64 + 8 * fq;
        const float sc = (u.pn >= sc_lo && u.pn < sc_hi) ? scale : 1.f;
#pragma unroll
        for (int ai = 0; ai < 2; ++ai)
#pragma unroll
            for (int m = 0; m < 4; ++m) { bf16* rowp = Ob + (size_t)(row0 + ai * 128 + m * 16) * ld + col0; const float scr = RS ? sc * ((const GAS float*)RS)[row0 + ai * 128 + m * 16] : sc;
#pragma unroll
                for (int bj = 0; bj < 2; ++bj) { const f32x4 v0 = acc[ai][bj][m][0] * scr, v1 = acc[ai][bj][m][1] * scr;
                    v4u w; w.x = pg8::cvt_pk_bf16(v0[0], v0[1]); w.y = pg8::cvt_pk_bf16(v0[2], v0[3]); w.z = pg8::cvt_pk_bf16(v1[0], v1[1]); w.w = pg8::cvt_pk_bf16(v1[2], v1[3]);
                    if (Ob) *(v4u*)(rowp + bj * 32) = w; else asm volatile("" :: "v"(w)); } }
    }
};
struct EpiResidB {
    const bf16* R; bf16* O;
    static __device__ __forceinline__ int brow(int rho) { return 64 * (rho >> 5) + pg8::perm32(rho & 31); }
    template <class UnitT> __device__ __forceinline__ void operator()(const f32x4 (&acc)[2][2][4][2], const UnitT& u, int wr, int wc, int fr, int fq) const {
        const int row0 = u.pm * 256 + wr * 64 + fr, col0 = u.pn * 256 + wc * 64 + 8 * fq;
#pragma unroll
        for (int ai = 0; ai < 2; ++ai) { v4u rv[4][2];
#pragma unroll
            for (int m = 0; m < 4; ++m)
#pragma unroll
                for (int bj = 0; bj < 2; ++bj) rv[m][bj] = *(const GAS v4u*)(R + (size_t)(row0 + ai * 128 + m * 16) * D + col0 + bj * 32);
#pragma unroll
            for (int m = 0; m < 4; ++m)
#pragma unroll
                for (int bj = 0; bj < 2; ++bj) { const f32x4 v0 = acc[ai][bj][m][0], v1 = acc[ai][bj][m][1]; const v4u q = rv[m][bj]; v4u w;
                    w.x = pg8::cvt_pk_bf16(v0[0] + bflo(q.x), v0[1] + bfhi(q.x)); w.y = pg8::cvt_pk_bf16(v0[2] + bflo(q.y), v0[3] + bfhi(q.y));
                    w.z = pg8::cvt_pk_bf16(v1[0] + bflo(q.z), v1[1] + bfhi(q.z)); w.w = pg8::cvt_pk_bf16(v1[2] + bflo(q.w), v1[3] + bfhi(q.w));
                    *(GAS v4u*)(O + (size_t)(row0 + ai * 128 + m * 16) * D + col0 + bj * 32) = w; } }
    }
};
struct EpiEvIn {
    bf16* O; const float* qg; const float* kg; const float* RS;
    static __device__ __forceinline__ int brow(int rho) { return 64 * (rho >> 5) + pg8::perm32(rho & 31); }
    __device__ __forceinline__ void operator()(const f32x4 (&acc)[2][2][4][2], const pg8::Unit& u, int wr, int wc, int fr, int fq) const {
        const int row0 = u.pm * 256 + wr * 64 + fr, col0 = u.pn * 256 + wc * 64 + 8 * fq;
        float rsv[2][4];
#pragma unroll
        for (int ai = 0; ai < 2; ++ai)
#pragma unroll
            for (int m = 0; m < 4; ++m) rsv[ai][m] = ((const GAS float*)RS)[row0 + ai * 128 + m * 16];
        const bool nrm = u.pn < 4; const float* gp = (u.pn < 2) ? qg : kg; const float post = (u.pn < 2) ? 0.125f : 1.f;
        f32x4 g[2][2];
#pragma unroll
        for (int bj = 0; bj < 2; ++bj)
#pragma unroll
            for (int n = 0; n < 2; ++n) g[bj][n] = nrm ? *(const f32x4*)(gp + 32 * bj + 8 * fq + 4 * n) * post : (f32x4){1.f, 1.f, 1.f, 1.f};
#pragma unroll
        for (int ai = 0; ai < 2; ++ai)
#pragma unroll
            for (int m = 0; m < 4; ++m) {
                float r = rsv[ai][m];
                if (nrm) { float ss = 0.f;
#pragma unroll
                    for (int bj = 0; bj < 2; ++bj)
#pragma unroll
                        for (int n = 0; n < 2; ++n) { const f32x4 x = acc[ai][bj][m][n]; ss += (x[0] * x[0] + x[1] * x[1]) + (x[2] * x[2] + x[3] * x[3]); }
                    ss += shx(ss, 16, fq * 16 + fr); ss += shx(ss, 32, fq * 16 + fr);
                    r = r * rsqrtf(r * r * ss * (1.f / 64.f) + RMS_EPS); }
                bf16* rowp = O + (size_t)(row0 + ai * 128 + m * 16) * PU + col0;
#pragma unroll
                for (int bj = 0; bj < 2; ++bj) { const f32x4 v0 = acc[ai][bj][m][0] * r * g[bj][0], v1 = acc[ai][bj][m][1] * r * g[bj][1];
                    v4u w; w.x = pg8::cvt_pk_bf16(v0[0], v0[1]); w.y = pg8::cvt_pk_bf16(v0[2], v0[3]); w.z = pg8::cvt_pk_bf16(v1[0], v1[1]); w.w = pg8::cvt_pk_bf16(v1[2], v1[3]);
                    *(v4u*)(rowp + bj * 32) = w; } }
    }
};
struct EpiResid {
    const float* resid; float* out;
    static __device__ __forceinline__ int brow(int rho) { return rho; }
    __device__ __forceinline__ void operator()(const f32x4 (&acc)[2][2][4][2], const pg8::Unit& u, int wr, int wc, int fr, int fq) const {
        const int row0 = u.pm * 256 + wr * 64 + fr, col0 = u.pn * 256 + wc * 32 + 4 * fq;
#pragma unroll
        for (int ai = 0; ai < 2; ++ai)
#pragma unroll
            for (int m = 0; m < 4; ++m) { const size_t off = (size_t)(row0 + ai * 128 + m * 16) * D + col0;
#pragma unroll
                for (int bj = 0; bj < 2; ++bj)
#pragma unroll
                    for (int n = 0; n < 2; ++n) { const f32x4 b = *(const f32x4*)(resid + off + bj * 128 + n * 16); *(f32x4*)(out + off + bj * 128 + n * 16) = b + acc[ai][bj][m][n]; } }
    }
};
struct EpiMoe1 {
    bf16* H; LAS const float* rst;
    static __device__ __forceinline__ int brow(int rho) { return (rho & ~31) + pg8::perm32(rho & 31); }
    __device__ __forceinline__ void operator()(const f32x4 (&acc)[2][2][4][2], const pg8::UnitM& u, int wr, int wc, int fr, int fq) const {
        const int row0 = u.pm * 256 + wr * 64 + fr, col0 = u.pn * 128 + wc * 32 + 8 * fq;
#pragma unroll
        for (int ai = 0; ai < 2; ++ai)
#pragma unroll
            for (int m = 0; m < 4; ++m) { bf16* rowp = H + (size_t)(row0 + ai * 128 + m * 16) * FF + col0; float o[8]; const float rr = rst[u.par * 256 + wr * 64 + ai * 128 + m * 16 + fr];
#pragma unroll
                for (int n = 0; n < 2; ++n)
#pragma unroll
                    for (int i = 0; i < 4; ++i) { const float g = acc[ai][0][m][n][i] * rr, up = acc[ai][1][m][n][i] * rr; o[4 * n + i] = g * __builtin_amdgcn_rcpf(1.f + __expf(-g)) * up; }
                v4u w; w.x = pg8::cvt_pk_bf16(o[0], o[1]); w.y = pg8::cvt_pk_bf16(o[2], o[3]); w.z = pg8::cvt_pk_bf16(o[4], o[5]); w.w = pg8::cvt_pk_bf16(o[6], o[7]);
                asm volatile("global_store_dwordx4 %0, %1, off sc1\n\ts_nop 1" :: "v"(rowp), "v"(w) : "memory"); }
    }
};

struct Frame {
    LAS unsigned char* lds; volatile LAS unsigned* MISC;
    int tid, lane, wave, vcu, G, bx;
};

typedef short s16x4 __attribute__((ext_vector_type(4)));
__device__ __forceinline__ bf16x8 lds_tr_frag(const LAS unsigned char* a, int row4_bytes) {
    const s16x4 lo = __builtin_amdgcn_ds_read_tr16_b64_v4i16((LAS s16x4*)a), hi = __builtin_amdgcn_ds_read_tr16_b64_v4i16((LAS s16x4*)(a + row4_bytes));
    return (bf16x8){lo[0], lo[1], lo[2], lo[3], hi[0], hi[1], hi[2], hi[3]};
}
__device__ __forceinline__ void convert_weights(Frame& F, const float* W, int Kd, int Nd, int ldw, size_t src_stride, bf16* WT, size_t dst_stride, int nmat, int gw_ = -1, int ngw_ = 0, const float* rowscale = nullptr) {
    constexpr int TP = 144;
    LAS unsigned char* tl = F.lds + F.wave * 9216;
    const int gw = gw_ >= 0 ? gw_ : F.vcu * 8 + F.wave, NGW = gw_ >= 0 ? ngw_ : F.G * 8, lane = F.lane, l16 = lane & 15, lq = lane >> 4;
    const int nblk = Nd / 64, per = (Kd / 64) * nblk, total = per * nmat;
    f32x4 nv[16];
    float nrs = 1.f;
    if (gw < total) { const int mtx = gw / per, r = gw % per, kb = r / nblk, nb = r % nblk;
        const float* src = W + (size_t)mtx * src_stride + (size_t)(64 * kb + lq) * ldw + 64 * nb + 4 * l16;
        { const float* rp = rowscale ? rowscale + 64 * kb + lane : W; nrs = *(const GAS float*)rp; }
#pragma unroll
        for (int i = 0; i < 16; ++i) nv[i] = __builtin_nontemporal_load((const GAS f32x4*)(src + (size_t)(4 * i) * ldw)); }
    for (int it = gw; it < total; it += NGW) { const int mtx = it / per, r = it % per, kb = r / nblk, nb = r % nblk;
        f32x4 v[16];
#pragma unroll
        for (int i = 0; i < 16; ++i) v[i] = nv[i];
        const float crs = rowscale ? nrs : 1.f;
        if (it + NGW < total) { const int it2 = it + NGW, mtx2 = it2 / per, r2 = it2 % per, kb2 = r2 / nblk, nb2 = r2 % nblk;
            const float* src = W + (size_t)mtx2 * src_stride + (size_t)(64 * kb2 + lq) * ldw + 64 * nb2 + 4 * l16;
            { const float* rp = rowscale ? rowscale + 64 * kb2 + lane : W; nrs = *(const GAS float*)rp; }
#pragma unroll
            for (int i = 0; i < 16; ++i) nv[i] = __builtin_nontemporal_load((const GAS f32x4*)(src + (size_t)(4 * i) * ldw)); }
#pragma unroll
        for (int i = 0; i < 16; ++i) { const int k = 4 * i + lq; const float sck = shf(crs, k);
            v2u w; w.x = pg8::cvt_pk_bf16(v[i][0] * sck, v[i][1] * sck); w.y = pg8::cvt_pk_bf16(v[i][2] * sck, v[i][3] * sck); *(LAS v2u*)(tl + k * TP + l16 * 8) = w; }
        asm volatile("s_waitcnt lgkmcnt(0)" ::: "memory");
        bf16* dst = WT + (size_t)mtx * dst_stride + (size_t)(64 * nb) * Kd + 64 * kb;
#pragma unroll
        for (int m4 = 0; m4 < 4; ++m4) { const int n0 = 16 * m4;
            const v4u X = __builtin_bit_cast(v4u, lds_tr_frag(tl + (8 * lq + (l16 >> 2)) * TP + (n0 + 4 * (l16 & 3)) * 2, 4 * TP));
            const v4u Y = __builtin_bit_cast(v4u, lds_tr_frag(tl + (32 + 8 * lq + (l16 >> 2)) * TP + (n0 + 4 * (l16 & 3)) * 2, 4 * TP));
            v4u Xr, Yr;
            Xr.x = (unsigned)__builtin_amdgcn_update_dpp(0, (int)X.x, 0x128, 0xF, 0xF, false); Xr.y = (unsigned)__builtin_amdgcn_update_dpp(0, (int)X.y, 0x128, 0xF, 0xF, false);
            Xr.z = (unsigned)__builtin_amdgcn_update_dpp(0, (int)X.z, 0x128, 0xF, 0xF, false); Xr.w = (unsigned)__builtin_amdgcn_update_dpp(0, (int)X.w, 0x128, 0xF, 0xF, false);
            Yr.x = (unsigned)__builtin_amdgcn_update_dpp(0, (int)Y.x, 0x128, 0xF, 0xF, false); Yr.y = (unsigned)__builtin_amdgcn_update_dpp(0, (int)Y.y, 0x128, 0xF, 0xF, false);
            Yr.z = (unsigned)__builtin_amdgcn_update_dpp(0, (int)Y.z, 0x128, 0xF, 0xF, false); Yr.w = (unsigned)__builtin_amdgcn_update_dpp(0, (int)Y.w, 0x128, 0xF, 0xF, false);
            const bool lo = l16 < 8; const int kb8 = 8 * (lq + 4 * (l16 >> 3));
            v4u A, B; A.x = lo ? X.x : Yr.x; A.y = lo ? X.y : Yr.y; A.z = lo ? X.z : Yr.z; A.w = lo ? X.w : Yr.w;
            B.x = lo ? Xr.x : Y.x; B.y = lo ? Xr.y : Y.y; B.z = lo ? Xr.z : Y.z; B.w = lo ? Xr.w : Y.w;
            *(GAS v4u*)(dst + (size_t)(n0 + (l16 & 7)) * Kd + kb8) = A;
            *(GAS v4u*)(dst + (size_t)(n0 + 8 + (l16 & 7)) * Kd + kb8) = B; }
        asm volatile("s_waitcnt lgkmcnt(0)" ::: "memory");
    }
}
struct ConvSeg { const float* W; bf16* WT; int Kd, Nd, ldw, nmat; size_t sstr, dstr; const float* rs;
    __device__ __forceinline__ int total() const { return (Kd / 64) * (Nd / 64) * nmat; } };
struct ConvItem { const float* src; bf16* dst; int ldw, Kd; const float* rs; };
template <int NS> __device__ __forceinline__ ConvItem conv_locate(const ConvSeg (&sg)[NS], int idx) {
    ConvItem o; o.src = sg[0].W; o.dst = sg[0].WT; o.ldw = sg[0].ldw; o.Kd = sg[0].Kd; o.rs = nullptr; int r = idx; bool found = false;
#pragma unroll
    for (int q = 0; q < NS; ++q) { const int tot = sg[q].total();
        if (!found && r < tot) { const int nblk = sg[q].Nd / 64, per = (sg[q].Kd / 64) * nblk, mtx = r / per, rr = r % per, kb = rr / nblk, nb = rr % nblk;
            o.src = sg[q].W + (size_t)mtx * sg[q].sstr + (size_t)(64 * kb) * sg[q].ldw + 64 * nb; o.dst = sg[q].WT + (size_t)mtx * sg[q].dstr + (size_t)(64 * nb) * sg[q].Kd + 64 * kb;
            o.ldw = sg[q].ldw; o.Kd = sg[q].Kd; o.rs = sg[q].rs ? sg[q].rs + 64 * kb : nullptr; found = true; }
        if (!found) r -= tot; }
    return o;
}
template <int NS> __device__ __forceinline__ void convert_multi(Frame& F, const ConvSeg (&sg)[NS], int gw, int NGW) {
    constexpr int TP = 144;
    LAS unsigned char* tl = F.lds + F.wave * 9216;
    const int lane = F.lane, l16 = lane & 15, lq = lane >> 4;
    int total = 0;
#pragma unroll
    for (int q = 0; q < NS; ++q) total += sg[q].total();
    f32x4 nv[16]; ConvItem cur = conv_locate<NS>(sg, gw < total ? gw : 0);
    float nrs = 1.f;
    if (gw < total) { const float* src = cur.src + (size_t)lq * cur.ldw + 4 * l16;
        { const float* rp = cur.rs ? cur.rs + lane : cur.src; nrs = *(const GAS float*)rp; }
#pragma unroll
        for (int i = 0; i < 16; ++i) nv[i] = __builtin_nontemporal_load((const GAS f32x4*)(src + (size_t)(4 * i) * cur.ldw)); }
    for (int it = gw; it < total; it += NGW) {
        f32x4 v[16];
#pragma unroll
        for (int i = 0; i < 16; ++i) v[i] = nv[i];
        const float crs = cur.rs ? nrs : 1.f;
        const bool more = it + NGW < total; const ConvItem nxt = conv_locate<NS>(sg, more ? it + NGW : 0);
        if (more) { const float* src = nxt.src + (size_t)lq * nxt.ldw + 4 * l16;
            { const float* rp = nxt.rs ? nxt.rs + lane : nxt.src; nrs = *(const GAS float*)rp; }
#pragma unroll
            for (int i = 0; i < 16; ++i) nv[i] = __builtin_nontemporal_load((const GAS f32x4*)(src + (size_t)(4 * i) * nxt.ldw)); }
#pragma unroll
        for (int i = 0; i < 16; ++i) { const int k = 4 * i + lq; const float sck = shf(crs, k);
            v2u w; w.x = pg8::cvt_pk_bf16(v[i][0] * sck, v[i][1] * sck); w.y = pg8::cvt_pk_bf16(v[i][2] * sck, v[i][3] * sck); *(LAS v2u*)(tl + k * TP + l16 * 8) = w; }
        asm volatile("s_waitcnt lgkmcnt(0)" ::: "memory");
        bf16* dst = cur.dst; const int Kd = cur.Kd;
#pragma unroll
        for (int m4 = 0; m4 < 4; ++m4) { const int n0 = 16 * m4;
            const v4u X = __builtin_bit_cast(v4u, lds_tr_frag(tl + (8 * lq + (l16 >> 2)) * TP + (n0 + 4 * (l16 & 3)) * 2, 4 * TP));
            const v4u Y = __builtin_bit_cast(v4u, lds_tr_frag(tl + (32 + 8 * lq + (l16 >> 2)) * TP + (n0 + 4 * (l16 & 3)) * 2, 4 * TP));
            v4u Xr, Yr;
            Xr.x = (unsigned)__builtin_amdgcn_update_dpp(0, (int)X.x, 0x128, 0xF, 0xF, false); Xr.y = (unsigned)__builtin_amdgcn_update_dpp(0, (int)X.y, 0x128, 0xF, 0xF, false);
            Xr.z = (unsigned)__builtin_amdgcn_update_dpp(0, (int)X.z, 0x128, 0xF, 0xF, false); Xr.w = (unsigned)__builtin_amdgcn_update_dpp(0, (int)X.w, 0x128, 0xF, 0xF, false);
            Yr.x = (unsigned)__builtin_amdgcn_update_dpp(0, (int)Y.x, 0x128, 0xF, 0xF, false); Yr.y = (unsigned)__builtin_amdgcn_update_dpp(0, (int)Y.y, 0x128, 0xF, 0xF, false);
            Yr.z = (unsigned)__builtin_amdgcn_update_dpp(0, (int)Y.z, 0x128, 0xF, 0xF, false); Yr.w = (unsigned)__builtin_amdgcn_update_dpp(0, (int)Y.w, 0x128, 0xF, 0xF, false);
            const bool lo = l16 < 8; const int kb8 = 8 * (lq + 4 * (l16 >> 3));
            v4u A, B; A.x = lo ? X.x : Yr.x; A.y = lo ? X.y : Yr.y; A.z = lo ? X.z : Yr.z; A.w = lo ? X.w : Yr.w;
            B.x = lo ? Xr.x : Y.x; B.y = lo ? Xr.y : Y.y; B.z = lo ? Xr.z : Y.z; B.w = lo ? Xr.w : Y.w;
            *(GAS v4u*)(dst + (size_t)(n0 + (l16 & 7)) * Kd + kb8) = A;
            *(GAS v4u*)(dst + (size_t)(n0 + 8 + (l16 & 7)) * Kd + kb8) = B; }
        asm volatile("s_waitcnt lgkmcnt(0)" ::: "memory");
        cur = nxt;
    }
}
__device__ __forceinline__ void rms_rows4_to_bf16(int lane, const float* x, const size_t (&ro)[4], float* RS, bf16* o) {
    f32x4 v[4][4];
#pragma unroll
    for (int r = 0; r < 4; ++r)
#pragma unroll
        for (int j = 0; j < 4; ++j) v[r][j] = __builtin_nontemporal_load((const GAS f32x4*)(x + ro[r]) + lane + 64 * j);
#pragma unroll
    for (int r = 0; r < 4; ++r) { float sa = 0.f;
#pragma unroll
        for (int j = 0; j < 4; ++j) sa += (v[r][j].x * v[r][j].x + v[r][j].y * v[r][j].y) + (v[r][j].z * v[r][j].z + v[r][j].w * v[r][j].w);
        const float r0 = rsqrtf(wave_sum(sa, lane) * (1.f / D) + RMS_EPS);
        if (lane == 0) RS[ro[r] / D] = r0;
        GAS v2u* pa = (GAS v2u*)(o + ro[r]) + lane;
#pragma unroll
        for (int j = 0; j < 4; ++j) { v2u w; w.x = pg8::cvt_pk_bf16(v[r][j].x, v[r][j].y); w.y = pg8::cvt_pk_bf16(v[r][j].z, v[r][j].w); pa[64 * j] = w; } }
}
__device__ __forceinline__ void rms_rows2_to_bf16(int lane, const float* xa, const float* xb, const float* gain, bf16* oa, bf16* ob) {
    const GAS f32x4* ra = (const GAS f32x4*)xa + lane; const GAS f32x4* rb = (const GAS f32x4*)xb + lane; const GAS f32x4* gr = (const GAS f32x4*)gain + lane;
    f32x4 va[4], vb[4]; float sa = 0.f, sb = 0.f;
#pragma unroll
    for (int j = 0; j < 4; ++j) { va[j] = __builtin_nontemporal_load(ra + 64 * j); vb[j] = __builtin_nontemporal_load(rb + 64 * j); }
#pragma unroll
    for (int j = 0; j < 4; ++j) { sa += (va[j].x * va[j].x + va[j].y * va[j].y) + (va[j].z * va[j].z + va[j].w * va[j].w); sb += (vb[j].x * vb[j].x + vb[j].y * vb[j].y) + (vb[j].z * vb[j].z + vb[j].w * vb[j].w); }
    const float r0 = rsqrtf(wave_sum(sa, lane) * (1.f / D) + RMS_EPS), r1 = rsqrtf(wave_sum(sb, lane) * (1.f / D) + RMS_EPS);
    GAS v2u* pa = (GAS v2u*)oa + lane; GAS v2u* pb = (GAS v2u*)ob + lane;
#pragma unroll
    for (int j = 0; j < 4; ++j) { const f32x4 g = gr[64 * j];
        v2u w; w.x = pg8::cvt_pk_bf16(va[j].x * r0 * g.x, va[j].y * r0 * g.y); w.y = pg8::cvt_pk_bf16(va[j].z * r0 * g.z, va[j].w * r0 * g.w); pa[64 * j] = w;
        v2u u; u.x = pg8::cvt_pk_bf16(vb[j].x * r1 * g.x, vb[j].y * r1 * g.y); u.y = pg8::cvt_pk_bf16(vb[j].z * r1 * g.z, vb[j].w * r1 * g.w); pb[64 * j] = u; }
}

struct Args { const float* in[20]; float* out; unsigned char* ws; int ph_lo, ph_hi; };

__device__ __forceinline__ void final_combine(Frame& F, const bf16* X1, const bf16* Y, const int* eid, const float* gate, const int* rel, float* out) {
    const int gw = F.vcu * 8 + F.wave, NGW = F.G * 8, lane = F.lane;
    LAS const int* tab = (LAS const int*)(F.lds + MOE_TAB_OFF);
    for (int tb = gw; tb < T; tb += 16 * NGW) {
        const int tk = tb + (lane & 15) * NGW; const bool ok = tk < T; const int tq = ok ? tk : tb;
        const int s0 = 256 * tab[eid[2 * tq]] + rel[2 * tq], s1 = 256 * tab[eid[2 * tq + 1]] + rel[2 * tq + 1]; const float g0 = gate[2 * tq], g1 = gate[2 * tq + 1];
        for (int k = 0; k < 16; k += 2) { const int ta = tb + k * NGW, tc = ta + NGW; if (ta >= T) break; const bool two = tc < T; const int tcq = two ? tc : ta;
            const int k1 = two ? k + 1 : k;
            const int a0 = __builtin_amdgcn_readlane(s0, k), a1 = __builtin_amdgcn_readlane(s1, k), c0 = __builtin_amdgcn_readlane(s0, k1), c1 = __builtin_amdgcn_readlane(s1, k1);
            const float ga0 = __builtin_bit_cast(float, __builtin_amdgcn_readlane(__builtin_bit_cast(int, g0), k)), ga1 = __builtin_bit_cast(float, __builtin_amdgcn_readlane(__builtin_bit_cast(int, g1), k)),
                        gc0 = __builtin_bit_cast(float, __builtin_amdgcn_readlane(__builtin_bit_cast(int, g0), k1)), gc1 = __builtin_bit_cast(float, __builtin_amdgcn_readlane(__builtin_bit_cast(int, g1), k1));
            v2u xa_[4], xc_[4]; f32x4 va[4], vc[4]; v2u ya0[4], ya1[4], yc0[4], yc1[4];
#pragma unroll
            for (int j = 0; j < 4; ++j) { xa_[j] = __builtin_nontemporal_load(((const GAS v2u*)(X1 + (size_t)ta * D) + lane + 64 * j)); xc_[j] = __builtin_nontemporal_load(((const GAS v2u*)(X1 + (size_t)tcq * D) + lane + 64 * j));
                ya0[j] = __builtin_nontemporal_load(((const GAS v2u*)(Y + (size_t)a0 * D) + lane + 64 * j)); ya1[j] = __builtin_nontemporal_load(((const GAS v2u*)(Y + (size_t)a1 * D) + lane + 64 * j));
                yc0[j] = __builtin_nontemporal_load(((const GAS v2u*)(Y + (size_t)c0 * D) + lane + 64 * j)); yc1[j] = __builtin_nontemporal_load(((const GAS v2u*)(Y + (size_t)c1 * D) + lane + 64 * j)); }
#pragma unroll
            for (int j = 0; j < 4; ++j) { va[j] = (f32x4){bflo(xa_[j].x), bfhi(xa_[j].x), bflo(xa_[j].y), bfhi(xa_[j].y)}; vc[j] = (f32x4){bflo(xc_[j].x), bfhi(xc_[j].x), bflo(xc_[j].y), bfhi(xc_[j].y)}; }
#pragma unroll
            for (int j = 0; j < 4; ++j) { f32x4 v = va[j];
                v.x += ga0 * bflo(ya0[j].x) + ga1 * bflo(ya1[j].x); v.y += ga0 * bfhi(ya0[j].x) + ga1 * bfhi(ya1[j].x); v.z += ga0 * bflo(ya0[j].y) + ga1 * bflo(ya1[j].y); v.w += ga0 * bfhi(ya0[j].y) + ga1 * bfhi(ya1[j].y);
                *((GAS f32x4*)(out + (size_t)ta * D) + lane + 64 * j) = v; }
            if (two) {
#pragma unroll
                for (int j = 0; j < 4; ++j) { f32x4 v = vc[j];
                    v.x += gc0 * bflo(yc0[j].x) + gc1 * bflo(yc1[j].x); v.y += gc0 * bfhi(yc0[j].x) + gc1 * bfhi(yc1[j].x); v.z += gc0 * bflo(yc0[j].y) + gc1 * bflo(yc1[j].y); v.w += gc0 * bfhi(yc0[j].y) + gc1 * bfhi(yc1[j].y);
                    *((GAS f32x4*)(out + (size_t)tc * D) + lane + 64 * j) = v; } }
        }
    }
}

constexpr int ML_L = 128, ML_NC = SEQ / ML_L, ML_P = ML_L * 2 + 16;
__device__ __forceinline__ void m2_phase(Frame& F, const bf16* __restrict__ DC, bf16* __restrict__ CP, const float* __restrict__ DN, float* __restrict__ NP, const float* __restrict__ SCg, const float* __restrict__ SCm, float* __restrict__ SCp) {
    const int gt = F.vcu * 512 + F.tid, NT = F.G * 512;
    for (int i = gt; i < 64 * 2048; i += NT) {
        const int bhd = __builtin_amdgcn_readfirstlane(i >> 11), e4 = i & 2047;
        const bool nw = __builtin_amdgcn_readfirstlane(e4) < 64;
        const float gv = SCg[bhd * ML_NC + (F.lane & (ML_NC - 1))], mv = SCm[bhd * ML_NC + (F.lane & (ML_NC - 1))];
        float C0 = 0.f, C1 = 0.f, C2 = 0.f, C3 = 0.f, m = 0.f, n = 0.f;
#pragma unroll 1
        for (int c0 = 0; c0 < ML_NC; c0 += 16) { v2u dv[16]; float dn[16];
#pragma unroll
            for (int q = 0; q < 16; ++q) dv[q] = __builtin_nontemporal_load((const GAS v2u*)((const GAS char*)DC + (size_t)(bhd * ML_NC + c0 + q) * 16384 + (unsigned)(e4 * 8)));
            if (nw) {
#pragma unroll
                for (int q = 0; q < 16; ++q) dn[q] = *(const GAS float*)(DN + (size_t)(bhd * ML_NC + c0 + q) * 64 + e4); }
            else {
#pragma unroll
                for (int q = 0; q < 16; ++q) dn[q] = 0.f; }
#pragma unroll
            for (int q = 0; q < 16; ++q) { const int cd = bhd * ML_NC + c0 + q;
                const float g = __builtin_bit_cast(float, __builtin_amdgcn_readlane(__builtin_bit_cast(int, gv), c0 + q)), ml = __builtin_bit_cast(float, __builtin_amdgcn_readlane(__builtin_bit_cast(int, mv), c0 + q));
                const float mn = fmaxf(g + m, ml), a = __expf(g + m - mn), cc = __expf(ml - mn);
                v2u o; o.x = pg8::cvt_pk_bf16(C0, C1); o.y = pg8::cvt_pk_bf16(C2, C3); *(GAS v2u*)((GAS char*)CP + (size_t)cd * 16384 + (unsigned)(e4 * 8)) = o;
                if (nw) { *(GAS float*)(NP + (size_t)cd * 64 + e4) = n; if (e4 == 0) *(GAS float*)(SCp + cd) = m; }
                C0 = a * C0 + cc * bflo(dv[q].x); C1 = a * C1 + cc * bfhi(dv[q].x); C2 = a * C2 + cc * bflo(dv[q].y); C3 = a * C3 + cc * bfhi(dv[q].y);
                n = a * n + cc * dn[q]; m = mn; } }
    }
}

#define MFMA16(a, b, c) __builtin_amdgcn_mfma_f32_16x16x32_bf16((a), (b), (c), 0, 0, 0)
__device__ __forceinline__ bf16x8 pack8(const f32x4 lo, const f32x4 hi) {
    v4u w; w.x = pg8::cvt_pk_bf16(lo[0], lo[1]); w.y = pg8::cvt_pk_bf16(lo[2], lo[3]); w.z = pg8::cvt_pk_bf16(hi[0], hi[1]); w.w = pg8::cvt_pk_bf16(hi[2], hi[3]);
    return __builtin_bit_cast(bf16x8, w);
}
__device__ __forceinline__ bf16x8 scale8(const bf16x8 x, const float s) {
    const v4u u = __builtin_bit_cast(v4u, x); v4u w;
    w.x = pg8::cvt_pk_bf16(bflo(u.x) * s, bfhi(u.x) * s); w.y = pg8::cvt_pk_bf16(bflo(u.y) * s, bfhi(u.y) * s);
    w.z = pg8::cvt_pk_bf16(bflo(u.z) * s, bfhi(u.z) * s); w.w = pg8::cvt_pk_bf16(bflo(u.w) * s, bfhi(u.w) * s);
    return __builtin_bit_cast(bf16x8, w);
}
constexpr int ML_RS = 144;
template <int P> __device__ __forceinline__ void vT_put(LAS unsigned char* vT, const v4u x, int p) {
    const int row = p >> 4, pc = p & 15; LAS unsigned short* d = (LAS unsigned short*)(vT + (pc * 8) * P + row * 2);
    d[0 * (P / 2)] = (unsigned short)(x.x & 0xffff); d[1 * (P / 2)] = (unsigned short)(x.x >> 16);
    d[2 * (P / 2)] = (unsigned short)(x.y & 0xffff); d[3 * (P / 2)] = (unsigned short)(x.y >> 16);
    d[4 * (P / 2)] = (unsigned short)(x.z & 0xffff); d[5 * (P / 2)] = (unsigned short)(x.z >> 16);
    d[6 * (P / 2)] = (unsigned short)(x.w & 0xffff); d[7 * (P / 2)] = (unsigned short)(x.w >> 16);
}
__device__ __forceinline__ void ml_cumsum2(float f0, float f1, int lane, float& b0, float& b1) {
    const float s = dpp_scan_add(f0 + f1);
    const float ex = s - (f0 + f1); b0 = ex + f0; b1 = s;
}
__device__ __forceinline__ void ml_cummax2(float& p0, float& p1, int lane) {
    p1 = fmaxf(p0, p1); const float m = dpp_scan_max(p1);
    const float y = shup(m, 1, lane); const float ex = lane >= 1 ? y : -3.0e38f;
    p0 = fmaxf(p0, ex); p1 = fmaxf(p1, ex);
}
struct M1Raw { v4u k[2], v[4]; float ig[2], fg[2]; };
__device__ __forceinline__ void m1_fetch(M1Raw& R, const bf16* U, const float* GATES, int it, int tid, int lane, int wave) {
    const int j = it & (ML_NC - 1), h = (it >> 5) & 7, b = it >> 8; const size_t t0 = (size_t)b * SEQ + ML_L * j;
#pragma unroll
    for (int i = 0; i < 2; ++i) { const int p = tid + 512 * i, row = p >> 3, pc = p & 7; R.k[i] = *(const GAS v4u*)(U + (t0 + row) * PQK + 512 + h * 64 + pc * 8); }
#pragma unroll
    for (int i = 0; i < 4; ++i) { const int p = tid + 512 * i, row = p >> 4, pc = p & 15; R.v[i] = *(const GAS v4u*)(U + VO_OFF + (t0 + row) * PVO + h * 128 + pc * 8); }
    const int dir = wave & 1;
#pragma unroll
    for (int q = 0; q < 2; ++q) { const int lam = 2 * lane + q, tl = dir ? ML_L - 1 - lam : lam;
        R.ig[q] = GATES[(size_t)((2 * dir) * 8 + h) * T + t0 + tl]; R.fg[q] = GATES[(size_t)((2 * dir + 1) * 8 + h) * T + t0 + tl]; }
}
__device__ __forceinline__ void m1_mfma(Frame& F, const bf16* U, const float* GATES, bf16* DC, float* DN, float* SCg, float* SCm) {
    LAS unsigned char* kw0 = F.lds; LAS unsigned char* vT = F.lds + 36864; LAS float* wt = (LAS float*)(F.lds + 71680);
    const int tid = F.tid, lane = F.lane, fr = lane & 15, fq = lane >> 4;
    constexpr int NU = NB * 8 * ML_NC;
    M1Raw R;
    if (F.vcu < NU) m1_fetch(R, U, GATES, F.vcu, tid, lane, F.wave);
    for (int it = F.vcu; it < NU; it += F.G) {
        const int j = it & (ML_NC - 1), h = (it >> 5) & 7, b = it >> 8;
        __syncthreads();
        if (F.wave < 2) { const int dir = F.wave, c = dir ? ML_NC - 1 - j : j, cd = ((b * 8 + h) * 2 + dir) * ML_NC + c;
            float b0, b1; ml_cumsum2(log_sigmoid(R.fg[0]), log_sigmoid(R.fg[1]), lane, b0, b1);
            const float g = lane63(b1); const float w0 = g - b0 + R.ig[0], w1 = g - b1 + R.ig[1]; const float ml = lane63(dpp_scan_max(fmaxf(w0, w1)));
            const int l0 = 2 * lane, t0l = dir ? ML_L - 1 - l0 : l0, t1l = dir ? ML_L - 2 - l0 : l0 + 1;
            wt[dir * ML_L + t0l] = __expf(w0 - ml); wt[dir * ML_L + t1l] = __expf(w1 - ml);
            if (lane == 0) { SCg[cd] = g; SCm[cd] = ml; } }
#pragma unroll
        for (int i = 0; i < 4; ++i) { const int p = tid + 512 * i, row = p >> 4, pc = p & 15; *(LAS v4u*)(vT + row * ML_P + pc * 16) = R.v[i]; }
        __syncthreads();
#pragma unroll
        for (int i2 = 0; i2 < 2; ++i2) { const int p = tid + 512 * i2, row = p >> 3, pc = p & 7; const bf16x8 x = __builtin_bit_cast(bf16x8, R.k[i2]);
          *(LAS bf16x8*)(kw0 + row * ML_RS + pc * 16) = scale8(x, wt[row]); *(LAS bf16x8*)(kw0 + ML_L * ML_RS + row * ML_RS + pc * 16) = scale8(x, wt[ML_L + row]); }
        __syncthreads();
        if (it + F.G < NU) m1_fetch(R, U, GATES, it + F.G, tid, lane, F.wave);
        { const int dir = F.wave >> 2, g = F.wave & 3, c = dir ? ML_NC - 1 - j : j, cd = ((b * 8 + h) * 2 + dir) * ML_NC + c;
          LAS unsigned char* kw = kw0 + dir * ML_L * ML_RS;
          bf16x8 afr[4][4];
#pragma unroll
          for (int mf = 0; mf < 4; ++mf)
#pragma unroll
              for (int t = 0; t < 4; ++t) afr[mf][t] = lds_tr_frag(kw + (32 * t + 8 * fq + (fr >> 2)) * ML_RS + (16 * mf + 4 * (fr & 3)) * 2, 4 * ML_RS);
          LAS unsigned char* st = F.lds + 73728 + F.wave * 4608;
          const int nef = (g == 0) ? 3 : 2;
          for (int q = 0; q < nef; ++q) { const int ef = (q == 2) ? 8 : 2 * g + q;
              bf16x8 bfr[4];
#pragma unroll
              for (int t = 0; t < 4; ++t) { if (ef < 8) bfr[t] = lds_tr_frag(vT + (32 * t + 8 * fq + (fr >> 2)) * ML_P + (16 * ef + 4 * (fr & 3)) * 2, 4 * ML_P);
                  else { const short one = (fr == 0) ? (short)0x3F80 : (short)0; bfr[t] = (bf16x8){one, one, one, one, one, one, one, one}; } }
#pragma unroll
              for (int mf = 0; mf < 4; ++mf) { f32x4 acc = {0.f, 0.f, 0.f, 0.f};
#pragma unroll
                  for (int t = 0; t < 4; ++t) acc = MFMA16(afr[mf][t], bfr[t], acc);
                  const int d0 = 16 * mf + 4 * fq;
                  if (ef < 8) { v2u w; w.x = pg8::cvt_pk_bf16(acc[0], acc[1]); w.y = pg8::cvt_pk_bf16(acc[2], acc[3]); *(LAS v2u*)(st + (16 * q + fr) * ML_RS + d0 * 2) = w; }
                  else if (fr == 0) *(GAS f32x4*)(DN + (size_t)cd * 64 + d0) = acc; } }
          asm volatile("s_waitcnt lgkmcnt(0)" ::: "memory");
#pragma unroll
          for (int i = 0; i < 4; ++i) { const int er = 8 * i + (lane >> 3), c8 = lane & 7;
              *(GAS v4u*)(DC + (size_t)cd * 8192 + (32 * g + er) * 64 + 8 * c8) = *(const LAS v4u*)(st + er * ML_RS + c8 * 16); }
          asm volatile("s_waitcnt lgkmcnt(0)" ::: "memory"); }
    }
}
struct M3Raw { v4u q[2], k[2], v[4], cp[4]; float ig[2], fg[2], mp; };
__device__ __forceinline__ void m3_fetch(M3Raw& R, const bf16* U, const float* GATES, const float* SCp, const bf16* CP, int it, int tid, int lane, int gdir) {
    const int j = it & (ML_NC - 1), h = (it >> 5) & 7, b = it >> 8; const size_t t0 = (size_t)b * SEQ + ML_L * j;
#pragma unroll
    for (int i = 0; i < 2; ++i) { const int p = tid + 512 * i, row = p >> 3, pc = p & 7;
        R.q[i] = *(const GAS v4u*)(U + (t0 + row) * PQK + h * 64 + pc * 8); R.k[i] = *(const GAS v4u*)(U + (t0 + row) * PQK + 512 + h * 64 + pc * 8); }
#pragma unroll
    for (int i = 0; i < 4; ++i) { const int p = tid + 512 * i, row = p >> 4, pc = p & 15; R.v[i] = *(const GAS v4u*)(U + VO_OFF + (t0 + row) * PVO + h * 128 + pc * 8); }
    const int c = gdir ? ML_NC - 1 - j : j, cd = ((b * 8 + h) * 2 + gdir) * ML_NC + c;
#pragma unroll
    for (int q = 0; q < 2; ++q) { const int lam = 2 * lane + q, tl = gdir ? ML_L - 1 - lam : lam;
        R.ig[q] = GATES[(size_t)((2 * gdir) * 8 + h) * T + t0 + tl]; R.fg[q] = GATES[(size_t)((2 * gdir + 1) * 8 + h) * T + t0 + tl]; }
    R.mp = SCp[cd];
#pragma unroll
    for (int dd = 0; dd < 2; ++dd) { const int c2 = dd ? ML_NC - 1 - j : j; const size_t cd2 = (size_t)(((b * 8 + h) * 2 + dd) * ML_NC + c2);
#pragma unroll
        for (int i = 0; i < 2; ++i) { const int p = tid + 512 * i; R.cp[dd * 2 + i] = __builtin_nontemporal_load((const GAS v4u*)(CP + cd2 * 8192 + p * 8)); } }
}
constexpr int M3_P = 288;
__device__ __forceinline__ void m3_dir(f32x4 (&hsum)[8], const int dir, const LAS unsigned char* qS, const LAS unsigned char* kS, const LAS unsigned char* vT, const LAS float* tb,
                                       const LAS unsigned char* cS, const float* NPcd, const int lf, const int fr, const int fq, const int lane) {
    f32x4 npv[2][2];
#pragma unroll
    for (int kd = 0; kd < 2; ++kd) { const float* np = NPcd + 8 * fq + 32 * kd; npv[kd][0] = *(const GAS f32x4*)np; npv[kd][1] = *(const GAS f32x4*)(np + 4); }
    const int l = 16 * lf + fr; const float bl_l = tb[l], mo_l = tb[2 * ML_L + l], iw_l = tb[3 * ML_L + l];
    bf16x8 qb[2];
#pragma unroll
    for (int kd = 0; kd < 2; ++kd) qb[kd] = *(const LAS bf16x8*)(qS + l * ML_RS + (8 * fq + 32 * kd) * 2);
    bf16x8 pb[4];
#define M3_ON(t) (dir ? (32 * (t) + 31 >= 16 * lf) : (32 * (t) <= 16 * lf + 15))
#pragma unroll
    for (int t = 0; t < 4; ++t) { f32x4 pt[2];
        if (!M3_ON(t)) { pb[t] = (bf16x8){0, 0, 0, 0, 0, 0, 0, 0}; continue; }
#pragma unroll
        for (int hf = 0; hf < 2; ++hf) { const int srow = 32 * t + 8 * (fr >> 2) + 4 * hf + (fr & 3); f32x4 acc = {0.f, 0.f, 0.f, 0.f};
#pragma unroll
            for (int kd = 0; kd < 2; ++kd) acc = MFMA16(*(const LAS bf16x8*)(kS + srow * ML_RS + (8 * fq + 32 * kd) * 2), qb[kd], acc);
            const int s0 = 32 * t + 8 * fq + 4 * hf; const f32x4 bs = *(const LAS f32x4*)(tb + s0), is = *(const LAS f32x4*)(tb + ML_L + s0);
#pragma unroll
            for (int r = 0; r < 4; ++r) { const int s = s0 + r; const bool ok = dir ? (s >= l) : (s <= l); acc[r] = ok ? acc[r] * __expf(bl_l - bs[r] + is[r] - mo_l) : 0.f; }
            pt[hf] = acc; }
        pb[t] = pack8(pt[0], pt[1]); }
    bf16x8 qs[2]; qs[0] = scale8(qb[0], iw_l); qs[1] = scale8(qb[1], iw_l);
    float sc;
    { f32x4 acc = {0.f, 0.f, 0.f, 0.f}; const short one = (fr == 0) ? (short)0x3F80 : (short)0; const bf16x8 a1 = (bf16x8){one, one, one, one, one, one, one, one};
#pragma unroll
      for (int t = 0; t < 4; ++t) if (M3_ON(t)) acc = MFMA16(a1, pb[t], acc);
#pragma unroll
      for (int kd = 0; kd < 2; ++kd) { const bf16x8 pk = pack8(npv[kd][0], npv[kd][1]); const bf16x8 a = (fr == 0) ? pk : (bf16x8){0, 0, 0, 0, 0, 0, 0, 0}; acc = MFMA16(a, qs[kd], acc); }
      const float den = shf(acc[0], fr); sc = __builtin_amdgcn_rcpf(fmaxf(fabsf(den), __expf(-mo_l))); }
    const LAS unsigned char* vb = vT + (8 * fq + (fr >> 2)) * M3_P + 8 * (fr & 3);
#pragma unroll
    for (int ef = 0; ef < 8; ++ef) { f32x4 acc = {0.f, 0.f, 0.f, 0.f};
        if ((ef & 3) == 0) __builtin_amdgcn_sched_barrier(0);
#pragma unroll
        for (int t = 0; t < 4; ++t) if (M3_ON(t)) acc = MFMA16(lds_tr_frag(vb + (32 * t) * M3_P + 32 * ef, 4 * M3_P), pb[t], acc);
#pragma unroll
        for (int kd = 0; kd < 2; ++kd) acc = MFMA16(*(const LAS bf16x8*)(cS + (16 * ef + fr) * ML_RS + (8 * fq + 32 * kd) * 2), qs[kd], acc);
        hsum[ef] += acc * sc; }
}
__device__ __forceinline__ void m3_mfma(Frame& F, const bf16* U, const float* GATES, const bf16* CP, const float* NP, const float* SCp, const float* h_gain, bf16* MIX) {
    const int tid = F.tid, lane = F.lane, fr = lane & 15, fq = lane >> 4, lf = F.wave;
    LAS unsigned char* qS = F.lds; LAS unsigned char* kS = F.lds + 18432; LAS unsigned char* vT = F.lds + 36864; LAS float* tb2 = (LAS float*)(F.lds + 73728);
    const int gdir = lf & 1;
    constexpr int NU = NB * 8 * ML_NC;
    M3Raw R;
    LAS unsigned char* cS2 = F.lds + 77824;
    if (F.vcu < NU) m3_fetch(R, U, GATES, SCp, CP, F.vcu, tid, lane, gdir);
    LAS float* hgS = (LAS float*)(F.lds + 114688);
    if (tid < 128) hgS[tid] = h_gain[((F.vcu >> 5) & 7) * 128 + tid];
    for (int it = F.vcu; it < NU; it += F.G) {
        const int j = it & (ML_NC - 1), h = (it >> 5) & 7, b = it >> 8; const size_t t0 = (size_t)b * SEQ + ML_L * j;
        __syncthreads();
#pragma unroll
        for (int dd = 0; dd < 2; ++dd)
#pragma unroll
            for (int i = 0; i < 2; ++i) { const int p = tid + 512 * i, row = p >> 3, pc = p & 7; *(LAS v4u*)(cS2 + dd * 18432 + row * ML_RS + pc * 16) = R.cp[dd * 2 + i]; }
#pragma unroll
        for (int i = 0; i < 2; ++i) { const int p = tid + 512 * i, row = p >> 3, pc = p & 7; *(LAS v4u*)(qS + row * ML_RS + pc * 16) = R.q[i]; *(LAS v4u*)(kS + row * ML_RS + pc * 16) = R.k[i]; }
#pragma unroll
        for (int i = 0; i < 4; ++i) { const int p = tid + 512 * i, row = p >> 4, pc = p & 15; *(LAS v4u*)(vT + row * M3_P + pc * 16) = R.v[i]; }
        if (lf < 2) { LAS float* tb = tb2 + gdir * 4 * ML_L;
            float b0, b1; ml_cumsum2(log_sigmoid(R.fg[0]), log_sigmoid(R.fg[1]), lane, b0, b1);
            float p0 = R.ig[0] - b0, p1 = R.ig[1] - b1; ml_cummax2(p0, p1, lane);
            const float il0 = b0 + R.mp, il1 = b1 + R.mp, mo0 = fmaxf(il0, b0 + p0), mo1 = fmaxf(il1, b1 + p1);
            const int l0 = 2 * lane, t0l = gdir ? ML_L - 1 - l0 : l0, t1l = gdir ? ML_L - 2 - l0 : l0 + 1;
            tb[t0l] = b0; tb[ML_L + t0l] = R.ig[0]; tb[2 * ML_L + t0l] = mo0; tb[3 * ML_L + t0l] = __expf(il0 - mo0);
            tb[t1l] = b1; tb[ML_L + t1l] = R.ig[1]; tb[2 * ML_L + t1l] = mo1; tb[3 * ML_L + t1l] = __expf(il1 - mo1); }
        __syncthreads();
        if (it + F.G < NU) m3_fetch(R, U, GATES, SCp, CP, it + F.G, tid, lane, gdir);
        const int l = 16 * lf + fr;
        f32x4 hsum[8];
#pragma unroll
        for (int ef = 0; ef < 8; ++ef) hsum[ef] = (f32x4){0.f, 0.f, 0.f, 0.f};
#pragma unroll
        for (int dir = 0; dir < 2; ++dir) { const int c = dir ? ML_NC - 1 - j : j, cd = ((b * 8 + h) * 2 + dir) * ML_NC + c;
            m3_dir(hsum, dir, qS, kS, vT, tb2 + dir * 4 * ML_L, cS2 + dir * 18432, NP + (size_t)cd * 64, lf, fr, fq, lane); }
        { float ss = 0.f;
            v2u ov[8];
#pragma unroll
            for (int ef = 0; ef < 8; ++ef) ov[ef] = *(const GAS v2u*)(U + VO_OFF + (t0 + l) * PVO + 1024 + h * 128 + 16 * ef + 4 * fq);
#pragma unroll
            for (int ef = 0; ef < 8; ++ef) ss += (hsum[ef][0] * hsum[ef][0] + hsum[ef][1] * hsum[ef][1]) + (hsum[ef][2] * hsum[ef][2] + hsum[ef][3] * hsum[ef][3]);
            ss += shx(ss, 16, lane); ss += shx(ss, 32, lane);
            const float r = rsqrtf(ss * (1.f / 128.f) + RMS_EPS);
#pragma unroll
            for (int ef = 0; ef < 8; ++ef) { const int e = 16 * ef + 4 * fq; const f32x4 g = *(const LAS f32x4*)(hgS + e);
                const float o0 = bflo(ov[ef].x), o1 = bfhi(ov[ef].x), o2 = bflo(ov[ef].y), o3 = bfhi(ov[ef].y);
                v2u w; w.x = pg8::cvt_pk_bf16(hsum[ef][0] * r * g[0] * __builtin_amdgcn_rcpf(1.f + __expf(-o0)), hsum[ef][1] * r * g[1] * __builtin_amdgcn_rcpf(1.f + __expf(-o1)));
                w.y = pg8::cvt_pk_bf16(hsum[ef][2] * r * g[2] * __builtin_amdgcn_rcpf(1.f + __expf(-o2)), hsum[ef][3] * r * g[3] * __builtin_amdgcn_rcpf(1.f + __expf(-o3)));
                *(GAS v2u*)(MIX + (t0 + l) * D + h * 128 + e) = w; } }
    }
}
struct NaRaw { v4u k[9], v[9]; bf16x8 q[2]; };
__device__ __forceinline__ void na_fetch_k(NaRaw& R, const bf16* U, int it, int tid) {
    const int rp = it & 31, h = (it >> 5) & 7, b = it >> 8, rs0 = min(max(2 * rp - 4, 0), 56);
#pragma unroll
    for (int i = 0; i < 9; ++i) { const int p = tid + 512 * i, key = p >> 3, pc = p & 7, kr = min(rs0 + (key >> 6), 63); const size_t tk = (size_t)b * SEQ + kr * 64 + (key & 63);
        R.k[i] = *(const GAS v4u*)(U + tk * PU + 512 + h * 64 + pc * 8); }
}
__device__ __forceinline__ void na_fetch_vq(NaRaw& R, const bf16* U, int it, int tid, int rsel, int jb, int fr, int fq) {
    const int rp = it & 31, h = (it >> 5) & 7, b = it >> 8, rs0 = min(max(2 * rp - 4, 0), 56);
#pragma unroll
    for (int i = 0; i < 9; ++i) { const int p = tid + 512 * i, key = p >> 3, pc = p & 7, kr = min(rs0 + (key >> 6), 63); const size_t tk = (size_t)b * SEQ + kr * 64 + (key & 63);
        R.v[i] = *(const GAS v4u*)(U + tk * PU + 1024 + h * 64 + pc * 8); }
    const size_t tq = (size_t)b * SEQ + (2 * rp + rsel) * 64 + 16 * jb + fr;
#pragma unroll
    for (int kd = 0; kd < 2; ++kd) R.q[kd] = *(const GAS bf16x8*)(U + tq * PU + h * 64 + 8 * fq + 32 * kd);
}
__device__ __forceinline__ void na_mfma(Frame& F, const bf16* U, const float* rel_bias, bf16* MIX) {
    constexpr int KP = 144;
    constexpr int NU = NB * 8 * 32;
    LAS unsigned char* vI = F.lds; LAS float* bt = (LAS float*)(F.lds + 576 * KP + 128);
    const int tid = F.tid, lane = F.lane, fr = lane & 15, fq = lane >> 4, rsel = F.wave >> 2, jb = F.wave & 3;
    NaRaw R;
    if (F.vcu < NU) { na_fetch_k(R, U, F.vcu, tid); na_fetch_vq(R, U, F.vcu, tid, rsel, jb, fr, fq); }
    int hb = -1;
    for (int it = F.vcu; it < NU; it += F.G) {
        const int rp = it & 31, h = (it >> 5) & 7, b = it >> 8, r0 = 2 * rp;
        const int rs0 = min(max(r0 - 4, 0), 56);
        const int r = r0 + rsel, rs = min(max(r - 4, 0), 56), rowoff = rs - rs0, bs = min(max(16 * jb - 8, 0), 32);
        const int qc = 16 * jb + fr, ws0 = min(max(qc - 8, 0), 48); const size_t tq = (size_t)b * SEQ + r * 64 + qc;
        __syncthreads();
        if (h != hb) { if (tid < 465) bt[tid] = rel_bias[h * 465 + tid]; hb = h; }
#pragma unroll
        for (int i = 0; i < 9; ++i) { const int p = tid + 512 * i, key = p >> 3, pc = p & 7; *(LAS v4u*)(vI + key * KP + pc * 16) = R.k[i]; }
        __syncthreads();
        f32x4 sc[8][2]; float mx = -3.0e38f;
        const int bidx0 = (rs - r + 7) * 31 + bs - qc + 15 + 8 * fq;
        const LAS unsigned char* krd = vI + (rowoff * 64 + bs + 8 * (fr >> 2) + (fr & 3)) * KP + 8 * fq * 2;
#pragma unroll
        for (int a = 0; a < 8; ++a) {
            float bb[2][4];
#pragma unroll
            for (int hf = 0; hf < 2; ++hf)
#pragma unroll
                for (int rg = 0; rg < 4; ++rg) bb[hf][rg] = ((volatile LAS float*)bt)[bidx0 + 31 * a + 4 * hf + rg];
#pragma unroll
            for (int hf = 0; hf < 2; ++hf) { f32x4 acc = {0.f, 0.f, 0.f, 0.f};
#pragma unroll
                for (int kd = 0; kd < 2; ++kd) acc = MFMA16(*(const LAS bf16x8*)(krd + (a * 64 + 4 * hf) * KP + 64 * kd), R.q[kd], acc);
#pragma unroll
                for (int rg = 0; rg < 4; ++rg) { const int kc = bs + 8 * fq + 4 * hf + rg; const bool ok = (kc >= ws0) && (kc < ws0 + 16);
                    const float v = ok ? acc[rg] + bb[hf][rg] : -3.0e38f; acc[rg] = v; mx = fmaxf(mx, v); }
                sc[a][hf] = acc; } }
        __syncthreads();
#pragma unroll
        for (int i = 0; i < 9; ++i) { const int p = tid + 512 * i, key = p >> 3, pc = p & 7; *(LAS v4u*)(vI + key * KP + pc * 16) = R.v[i]; }
        if (it + F.G < NU) { na_fetch_k(R, U, it + F.G, tid); na_fetch_vq(R, U, it + F.G, tid, rsel, jb, fr, fq); }
        mx = fmaxf(mx, shx(mx, 16, lane)); mx = fmaxf(mx, shx(mx, 32, lane));
        float sum = 0.f; bf16x8 pb[8];
#pragma unroll
        for (int a = 0; a < 8; ++a) {
#pragma unroll
            for (int hf = 0; hf < 2; ++hf)
#pragma unroll
                for (int rg = 0; rg < 4; ++rg) { const float p = __expf(sc[a][hf][rg] - mx); sc[a][hf][rg] = p; sum += p; }
            pb[a] = pack8(sc[a][0], sc[a][1]); }
        sum += shx(sum, 16, lane); sum += shx(sum, 32, lane);
        const float inv = __builtin_amdgcn_rcpf(sum);
        __syncthreads();
        const LAS unsigned char* vrd = vI + (rowoff * 64 + bs + 8 * fq + (fr >> 2)) * KP + (fr & 3) * 8;
#pragma unroll
        for (int df = 0; df < 4; ++df) { f32x4 acc = {0.f, 0.f, 0.f, 0.f};
#pragma unroll
            for (int a = 0; a < 8; ++a) acc = MFMA16(lds_tr_frag(vrd + a * 64 * KP + df * 32, 4 * KP), pb[a], acc);
            v2u w; w.x = pg8::cvt_pk_bf16(acc[0] * inv, acc[1] * inv); w.y = pg8::cvt_pk_bf16(acc[2] * inv, acc[3] * inv);
            *(GAS v2u*)(MIX + tq * D + h * 64 + 16 * df + 4 * fq) = w; }
    }
}

__device__ __forceinline__ void fourier1_mfma(Frame& F, const bf16* U, bf16* Y2, const LAS float* cs) {
    LAS unsigned char* T1 = F.lds; LAS unsigned char* xt = F.lds + 16384 + F.wave * 9216;
    const int tid = F.tid, lane = F.lane, fr = lane & 15, fq = lane >> 4;
    v4u xr[8];
    if (F.vcu * 8 + F.wave < NB * 8 * 64) { const int it = F.vcu * 8 + F.wave, b = it & 63, g = (it >> 6) & 7, bt = it >> 9;
#pragma unroll
        for (int i = 0; i < 8; ++i) { const int p = lane + 64 * i, a = p >> 3, pc = p & 7; xr[i] = *(const GAS v4u*)(U + ((size_t)bt * SEQ + 64 * a + b) * PU + 1536 + 64 * g + 8 * pc); } }
    __syncthreads();
    for (int e = tid; e < 1024; e += 512) { const int ln = e & 63, ks = (e >> 6) & 1, nf = e >> 7, col = 16 * nf + (ln & 15), u = col & 63, im = col >> 6; float v[8];
#pragma unroll
        for (int j = 0; j < 8; ++j) { const int a = 8 * (ln >> 4) + j + 32 * ks, k = (a * u) & 63; v[j] = cs[(im ? 64 : 0) + k] * (im ? -1.f : 1.f); }
        *(LAS bf16x8*)(T1 + e * 16) = pack8((f32x4){v[0], v[1], v[2], v[3]}, (f32x4){v[4], v[5], v[6], v[7]}); }
    __syncthreads();
    for (int it = F.vcu * 8 + F.wave; it < NB * 8 * 64; it += F.G * 8) {
        const int b = it & 63, g = (it >> 6) & 7, bt = it >> 9;
#pragma unroll
        for (int i = 0; i < 8; ++i) { const int p = lane + 64 * i, a = p >> 3, pc = p & 7; *(LAS v4u*)(xt + a * ML_RS + pc * 16) = xr[i]; }
        if (it + F.G * 8 < NB * 8 * 64) { const int i2 = it + F.G * 8, b2 = i2 & 63, g2 = (i2 >> 6) & 7, t2 = i2 >> 9;
#pragma unroll
            for (int i = 0; i < 8; ++i) { const int p = lane + 64 * i, a = p >> 3, pc = p & 7; xr[i] = *(const GAS v4u*)(U + ((size_t)t2 * SEQ + 64 * a + b2) * PU + 1536 + 64 * g2 + 8 * pc); } }
        asm volatile("s_waitcnt lgkmcnt(0)" ::: "memory");
        float tc[4], ts[4];
#pragma unroll
        for (int nfp = 0; nfp < 4; ++nfp) __sincosf(6.283185307179586f * (float)(b * (16 * nfp + fr)) * (1.f / 4096.f), &ts[nfp], &tc[nfp]);
        bf16* yb = Y2 + (size_t)(bt * 8 + g) * 64 * 64 * 128 + (size_t)b * 128;
#pragma unroll
        for (int mf = 0; mf < 4; ++mf) { bf16x8 af[2];
#pragma unroll
            for (int ks = 0; ks < 2; ++ks) af[ks] = lds_tr_frag(xt + (32 * ks + 8 * fq + (fr >> 2)) * ML_RS + (16 * mf + 4 * (fr & 3)) * 2, 4 * ML_RS);
#pragma unroll
            for (int nfp = 0; nfp < 4; ++nfp) { f32x4 re = {0.f, 0.f, 0.f, 0.f}, im = {0.f, 0.f, 0.f, 0.f};
#pragma unroll
                for (int ks = 0; ks < 2; ++ks) { re = MFMA16(af[ks], *(const LAS bf16x8*)(T1 + ((nfp * 2 + ks) * 64 + lane) * 16), re);
                    im = MFMA16(af[ks], *(const LAS bf16x8*)(T1 + (((nfp + 4) * 2 + ks) * 64 + lane) * 16), im); }
                const float c = tc[nfp] * 0.125f, sn = ts[nfp] * 0.125f; const int u = 16 * nfp + fr;
                v2u wr, wi; wr.x = pg8::cvt_pk_bf16(re[0] * c + im[0] * sn, re[1] * c + im[1] * sn); wr.y = pg8::cvt_pk_bf16(re[2] * c + im[2] * sn, re[3] * c + im[3] * sn);
                wi.x = pg8::cvt_pk_bf16(im[0] * c - re[0] * sn, im[1] * c - re[1] * sn); wi.y = pg8::cvt_pk_bf16(im[2] * c - re[2] * sn, im[3] * c - re[3] * sn);
                bf16* yp = yb + (size_t)u * 64 * 128 + 16 * mf + 4 * fq;
                *(v2u*)yp = wr; *(v2u*)(yp + 64) = wi; } }
        asm volatile("s_waitcnt lgkmcnt(0)" ::: "memory");
    }
}
__device__ __forceinline__ void fourier2_mfma(Frame& F, const bf16* Y2, bf16* MIX, const LAS float* cs) {
    LAS unsigned char* T2 = F.lds; LAS unsigned char* T3 = F.lds + 32768;
    const int tid = F.tid, lane = F.lane, fr = lane & 15, fq = lane >> 4;
    constexpr int NSL = NB * 8 * 64;
    bf16x8 af[4][4];
    if (F.vcu * 8 + F.wave < NSL) { const int it = F.vcu * 8 + F.wave, u = it & 63, g = (it >> 6) & 7, bt = it >> 9; const bf16* yb = Y2 + ((size_t)(bt * 8 + g) * 64 + u) * 64 * 128;
#pragma unroll
        for (int mf = 0; mf < 4; ++mf)
#pragma unroll
            for (int ks = 0; ks < 4; ++ks) af[mf][ks] = __builtin_nontemporal_load((const GAS bf16x8*)(yb + (size_t)(16 * mf + fr) * 128 + (ks >> 1) * 64 + 32 * (ks & 1) + 8 * fq)); }
    __syncthreads();
    for (int e = tid; e < 2048; e += 512) { const int ln = e & 63, ks = (e >> 6) & 3, nf = e >> 8, col = 16 * nf + (ln & 15), cp = col & 63, imo = col >> 6, imi = ks >> 1; float v[8];
#pragma unroll
        for (int j = 0; j < 8; ++j) { const int c = 32 * (ks & 1) + 8 * (ln >> 4) + j, k = (c * cp) & 63; v[j] = cs[((imi == imo) ? 0 : 64) + k] * ((imi == imo || imi) ? 1.f : -1.f); }
        *(LAS bf16x8*)(T2 + e * 16) = pack8((f32x4){v[0], v[1], v[2], v[3]}, (f32x4){v[4], v[5], v[6], v[7]}); }
    for (int e = tid; e < 1024; e += 512) { const int ln = e & 63, ks = (e >> 6) & 3, vf = e >> 8, vv = 16 * vf + (ln & 15), im = ks >> 1, t = ks & 1; float v[8];
#pragma unroll
        for (int j = 0; j < 8; ++j) { const int bb = 32 * t + 16 * (j >> 2) + 4 * (ln >> 4) + (j & 3), k = (vv * bb) & 63; v[j] = cs[(im ? 64 : 0) + k]; }
        *(LAS bf16x8*)(T3 + e * 16) = pack8((f32x4){v[0], v[1], v[2], v[3]}, (f32x4){v[4], v[5], v[6], v[7]}); }
    __syncthreads();
    for (int it = F.vcu * 8 + F.wave; it < NB * 8 * 64; it += F.G * 8) {
        const int u = it & 63, g = (it >> 6) & 7, bt = it >> 9;
#pragma unroll 1
        for (int nfp = 0; nfp < 4; ++nfp) {
            f32x4 wre[4], wim[4];
#pragma unroll
            for (int mf = 0; mf < 4; ++mf) { f32x4 re = {0.f, 0.f, 0.f, 0.f}, im = {0.f, 0.f, 0.f, 0.f};
#pragma unroll
                for (int ks = 0; ks < 4; ++ks) { re = MFMA16(af[mf][ks], *(const LAS bf16x8*)(T2 + ((nfp * 4 + ks) * 64 + lane) * 16), re);
                    im = MFMA16(af[mf][ks], *(const LAS bf16x8*)(T2 + (((nfp + 4) * 4 + ks) * 64 + lane) * 16), im); }
                wre[mf] = re; wim[mf] = im; }
            bf16x8 ap[4]; ap[0] = pack8(wre[0], wre[1]); ap[1] = pack8(wre[2], wre[3]); ap[2] = pack8(wim[0], wim[1]); ap[3] = pack8(wim[2], wim[3]);
#pragma unroll
            for (int vf = 0; vf < 4; ++vf) { f32x4 z = {0.f, 0.f, 0.f, 0.f};
#pragma unroll
                for (int ks = 0; ks < 4; ++ks) z = MFMA16(ap[ks], *(const LAS bf16x8*)(T3 + ((vf * 4 + ks) * 64 + lane) * 16), z);
                const size_t tok = (size_t)bt * SEQ + u + 64 * (16 * vf + fr);
                v2u w; w.x = pg8::cvt_pk_bf16(z[0] * (1.f / 64.f), z[1] * (1.f / 64.f)); w.y = pg8::cvt_pk_bf16(z[2] * (1.f / 64.f), z[3] * (1.f / 64.f));
                *(v2u*)(MIX + tok * D + 512 + 64 * g + 16 * nfp + 4 * fq) = w; }
        }
        if (it + F.G * 8 < NSL) { const int i2 = it + F.G * 8, u2 = i2 & 63, g2 = (i2 >> 6) & 7, b2 = i2 >> 9; const bf16* yb = Y2 + ((size_t)(b2 * 8 + g2) * 64 + u2) * 64 * 128;
#pragma unroll
            for (int mf = 0; mf < 4; ++mf)
#pragma unroll
                for (int ks = 0; ks < 4; ++ks) af[mf][ks] = __builtin_nontemporal_load((const GAS bf16x8*)(yb + (size_t)(16 * mf + fr) * 128 + (ks >> 1) * 64 + 32 * (ks & 1) + 8 * fq)); }
    }
}

template <bool RB, bool DELTA>
__device__ __forceinline__ void router_mfma(Frame& F, const void* resid_, bf16* X1o, const float* gain, const bf16* WR, const float* b_rg, const float* b_re,
                                            const bf16* XN, float* RSs, int* eid, float* gate, int* rel, unsigned* cnt, int* list) {
    const int lane = F.lane, fr = lane & 15, fq = lane >> 4, w = F.wave, tid = F.tid;
    LAS float* ssp = (LAS float*)F.lds; LAS float* Lp = (LAS float*)(F.lds + 1024); LAS float* Ls = (LAS float*)(F.lds + 1024 + 25088);
    bf16x8 wf[4][3];
#pragma unroll
    for (int s = 0; s < 4; ++s)
#pragma unroll
        for (int nf = 0; nf < 3; ++nf) wf[s][nf] = *(const GAS bf16x8*)(WR + (size_t)(16 * nf + fr) * D + 128 * w + 32 * s + 8 * fq);
    LAS int* tokE = (LAS int*)(F.lds + 32768); LAS float* tokG = (LAS float*)(F.lds + 32768 + 1024);
    LAS float* tokR = (LAS float*)(F.lds + 32768 + 3072);
    LAS float* bS = (LAS float*)(F.lds + 32768 + 2048);
    if (tid < 4) bS[tid] = b_rg[tid]; else if (tid >= 64 && tid < 96) bS[4 + tid - 64] = b_re[tid - 64];
    int gi = 0;
    const float* resid = (const float*)resid_; const bf16* residb = (const bf16*)resid_;
    f32x4 na[4], nb[4]; v4u nd[4], nr[4];
    { const size_t row = (size_t)F.vcu * 16 + fr; const size_t ro = row * D + 128 * w + 8 * fq; const bf16* dl = XN + ro;
#pragma unroll
      for (int s = 0; s < 4; ++s) { if (RB) nr[s] = __builtin_nontemporal_load((const GAS v4u*)(residb + ro + 32 * s)); else { na[s] = __builtin_nontemporal_load((const GAS f32x4*)(resid + ro + 32 * s)); nb[s] = __builtin_nontemporal_load((const GAS f32x4*)(resid + ro + 32 * s + 4)); }
          if (DELTA) nd[s] = __builtin_nontemporal_load((const GAS v4u*)(dl + 32 * s)); } }
    for (int it = F.vcu; it < T / 16; it += F.G) {
        const size_t row = (size_t)it * 16 + fr; bf16* xo = X1o + row * D + 128 * w + 8 * fq;
        f32x4 xa[4], xb[4]; float ss = 0.f;
        f32x4 acc[3] = {{0.f, 0.f, 0.f, 0.f}, {0.f, 0.f, 0.f, 0.f}, {0.f, 0.f, 0.f, 0.f}};
#pragma unroll
        for (int s = 0; s < 4; ++s) { const v4u p = DELTA ? nd[s] : (v4u){0u, 0u, 0u, 0u};
            if (RB) { const v4u q = nr[s]; xa[s] = (f32x4){bflo(q.x), bfhi(q.x), bflo(q.y), bfhi(q.y)}; xb[s] = (f32x4){bflo(q.z), bfhi(q.z), bflo(q.w), bfhi(q.w)}; } else { xa[s] = na[s]; xb[s] = nb[s]; }
            if (DELTA) { xa[s][0] += bflo(p.x); xa[s][1] += bfhi(p.x); xa[s][2] += bflo(p.y); xa[s][3] += bfhi(p.y); xb[s][0] += bflo(p.z); xb[s][1] += bfhi(p.z); xb[s][2] += bflo(p.w); xb[s][3] += bfhi(p.w); } }
        if (it + F.G < T / 16) { const size_t nrow = (size_t)(it + F.G) * 16 + fr; const size_t ro = nrow * D + 128 * w + 8 * fq; const bf16* dl = XN + ro;
#pragma unroll
            for (int s = 0; s < 4; ++s) { if (RB) nr[s] = __builtin_nontemporal_load((const GAS v4u*)(residb + ro + 32 * s)); else { na[s] = __builtin_nontemporal_load((const GAS f32x4*)(resid + ro + 32 * s)); nb[s] = __builtin_nontemporal_load((const GAS f32x4*)(resid + ro + 32 * s + 4)); }
                if (DELTA) nd[s] = __builtin_nontemporal_load((const GAS v4u*)(dl + 32 * s)); } }
#pragma unroll
        for (int s = 0; s < 4; ++s) { const bf16x8 xq = pack8(xa[s], xb[s]); if (DELTA) *(GAS bf16x8*)(xo + 32 * s) = xq;
            const v4u q = __builtin_bit_cast(v4u, xq); xa[s] = (f32x4){bflo(q.x), bfhi(q.x), bflo(q.y), bfhi(q.y)}; xb[s] = (f32x4){bflo(q.z), bfhi(q.z), bflo(q.w), bfhi(q.w)};
#pragma unroll
            for (int nf = 0; nf < 3; ++nf) acc[nf] = MFMA16(xq, wf[s][nf], acc[nf]); }
#pragma unroll
        for (int s = 0; s < 4; ++s) { const f32x4 a = xa[s], b = xb[s]; ss += (a[0] * a[0] + a[1] * a[1]) + (a[2] * a[2] + a[3] * a[3]) + (b[0] * b[0] + b[1] * b[1]) + (b[2] * b[2] + b[3] * b[3]); }
        ss += shx(ss, 16, lane); ss += shx(ss, 32, lane);
        __syncthreads();
        if (fq == 0) ssp[w * 16 + fr] = ss;
#pragma unroll
        for (int nf = 0; nf < 3; ++nf)
#pragma unroll
            for (int rg = 0; rg < 4; ++rg) Lp[(w * 16 + 4 * fq + rg) * 49 + 16 * nf + fr] = acc[nf][rg];
        __syncthreads();
        for (int i = tid; i < 16 * 48; i += 512) { const int tk = i / 48, n = i % 48; float v = 0.f, tot = 0.f;
#pragma unroll
            for (int q = 0; q < 8; ++q) { v += Lp[(q * 16 + tk) * 49 + n]; tot += ssp[q * 16 + tk]; }
            const float r = rsqrtf(tot * (1.f / D) + RMS_EPS);
            Ls[tk * 49 + n] = v * r; if (n == 0) tokR[gi * 16 + tk] = r; }
        __syncthreads();
        if (tid < 16) { const int t = it * 16 + tid; const LAS float* lp = Ls + tid * 49;
            float lg[4]; int gs = 0; float gm = -3.0e38f;
#pragma unroll
            for (int q = 0; q < 4; ++q) { lg[q] = lp[q] + bS[q]; if (lg[q] > gm) { gm = lg[q]; gs = q; } }
            float gden = 0.f;
#pragma unroll
            for (int q = 0; q < 4; ++q) gden += __expf(lg[q] - gm);
            const float p_top = __builtin_amdgcn_rcpf(gden);
            float m0 = -3.0e38f, m1 = -3.0e38f; int i0 = 0, i1 = 0;
#pragma unroll
            for (int q = 0; q < 8; ++q) { const float v = lp[4 + gs * 8 + q] + bS[4 + gs * 8 + q];
                if (v > m0) { m1 = m0; i1 = i0; m0 = v; i0 = q; } else if (v > m1) { m1 = v; i1 = q; } }
            const float e1 = __expf(m1 - m0), inv = __builtin_amdgcn_rcpf(1.f + e1);
            tokE[(gi * 16 + tid) * 2] = gs * 8 + i0; tokE[(gi * 16 + tid) * 2 + 1] = gs * 8 + i1; tokG[(gi * 16 + tid) * 2] = p_top * inv; tokG[(gi * 16 + tid) * 2 + 1] = p_top * e1 * inv; }
        ++gi;
    }
    __syncthreads();
    if (w == 0) { const bool live = lane < gi * 16; const int a0 = live ? tokE[lane * 2] : -1, a1 = live ? tokE[lane * 2 + 1] : -1;
        const unsigned long long lt = (1ull << lane) - 1ull; int r0 = 0, r1 = 0, mycount = 0;
        for (int e = 0; e < NE; ++e) { const unsigned long long m0 = __ballot(a0 == e), m1 = __ballot(a1 == e);
            if (a0 == e) r0 = __popcll(m0 & lt); if (a1 == e) r1 = __popcll(m0) + __popcll(m1 & lt); if (lane == e) mycount = __popcll(m0) + __popcll(m1); }
        int base = 0; if (lane < NE && mycount > 0) base = (int)__hip_atomic_fetch_add(cnt + 64 * lane, (unsigned)mycount, RLX_AGENT);
        const int b0 = shfi(base, a0 < 0 ? 0 : a0), b1 = shfi(base, a1 < 0 ? 0 : a1);
        if (live) { const int t = (F.vcu + (lane >> 4) * F.G) * 16 + (lane & 15); const int sa = b0 + r0, sb = b1 + r1;
            list[a0 * 16384 + sa] = t; list[a1 * 16384 + sb] = t; { const float r = tokR[lane]; RSs[a0 * 16384 + sa] = r; RSs[a1 * 16384 + sb] = r; }
            eid[2 * t] = a0; eid[2 * t + 1] = a1; rel[2 * t] = sa; rel[2 * t + 1] = sb; gate[2 * t] = tokG[lane * 2]; gate[2 * t + 1] = tokG[lane * 2 + 1]; } }
}
__device__ __forceinline__ void combine_gates_mfma(Frame& F, bf16* X1, const bf16* Y, const int* eid, const float* gate, const int* rel, float* RS,
                                                   const bf16* WGt, const float* gate_bias, float* GATES) {
    const int lane = F.lane, fr = lane & 15, fq = lane >> 4, w = F.wave, tid = F.tid;
    LAS const int* tab = (LAS const int*)(F.lds + MOE_TAB_OFF);
    LAS float* ssp = (LAS float*)F.lds; LAS float* Lp = (LAS float*)(F.lds + 1024);
    bf16x8 wf[4][2];
#pragma unroll
    for (int s = 0; s < 4; ++s)
#pragma unroll
        for (int nf = 0; nf < 2; ++nf) wf[s][nf] = *(const GAS bf16x8*)(WGt + (size_t)(16 * nf + fr) * D + 128 * w + 32 * s + 8 * fq);
    v4u nxr[4], np0[4], np1[4]; float ng0, ng1;
    { const size_t row = (size_t)F.vcu * 16 + fr; const bf16* xr = X1 + row * D + 128 * w + 8 * fq;
      const bf16* y0 = Y + (size_t)(256 * tab[eid[2 * row]] + rel[2 * row]) * D + 128 * w + 8 * fq; const bf16* y1 = Y + (size_t)(256 * tab[eid[2 * row + 1]] + rel[2 * row + 1]) * D + 128 * w + 8 * fq;
      ng0 = gate[2 * row]; ng1 = gate[2 * row + 1];
#pragma unroll
      for (int s = 0; s < 4; ++s) { nxr[s] = __builtin_nontemporal_load((const GAS v4u*)(xr + 32 * s)); np0[s] = __builtin_nontemporal_load((const GAS v4u*)(y0 + 32 * s)); np1[s] = __builtin_nontemporal_load((const GAS v4u*)(y1 + 32 * s)); } }
    for (int it = F.vcu; it < T / 16; it += F.G) {
        const size_t row = (size_t)it * 16 + fr; bf16* xr = X1 + row * D + 128 * w + 8 * fq;
        const float g0 = ng0, g1 = ng1;
        f32x4 xa[4], xb[4]; v4u pp[4], qq[4]; bf16x8 xqb[4]; float ss = 0.f;
#pragma unroll
        for (int s = 0; s < 4; ++s) { const v4u q = nxr[s]; xa[s] = (f32x4){bflo(q.x), bfhi(q.x), bflo(q.y), bfhi(q.y)}; xb[s] = (f32x4){bflo(q.z), bfhi(q.z), bflo(q.w), bfhi(q.w)}; pp[s] = np0[s]; qq[s] = np1[s]; }
        if (it + F.G < T / 16) { const size_t nrow = (size_t)(it + F.G) * 16 + fr; const bf16* nx = X1 + nrow * D + 128 * w + 8 * fq;
            const bf16* y0 = Y + (size_t)(256 * tab[eid[2 * nrow]] + rel[2 * nrow]) * D + 128 * w + 8 * fq; const bf16* y1 = Y + (size_t)(256 * tab[eid[2 * nrow + 1]] + rel[2 * nrow + 1]) * D + 128 * w + 8 * fq;
            ng0 = gate[2 * nrow]; ng1 = gate[2 * nrow + 1];
#pragma unroll
            for (int s = 0; s < 4; ++s) { nxr[s] = __builtin_nontemporal_load((const GAS v4u*)(nx + 32 * s)); np0[s] = __builtin_nontemporal_load((const GAS v4u*)(y0 + 32 * s)); np1[s] = __builtin_nontemporal_load((const GAS v4u*)(y1 + 32 * s)); } }
#pragma unroll
        for (int s = 0; s < 4; ++s) { f32x4 a = xa[s], b = xb[s]; const v4u p = pp[s], q = qq[s];
            a[0] += g0 * bflo(p.x) + g1 * bflo(q.x); a[1] += g0 * bfhi(p.x) + g1 * bfhi(q.x); a[2] += g0 * bflo(p.y) + g1 * bflo(q.y); a[3] += g0 * bfhi(p.y) + g1 * bfhi(q.y);
            b[0] += g0 * bflo(p.z) + g1 * bflo(q.z); b[1] += g0 * bfhi(p.z) + g1 * bfhi(q.z); b[2] += g0 * bflo(p.w) + g1 * bflo(q.w); b[3] += g0 * bfhi(p.w) + g1 * bfhi(q.w);
            { const bf16x8 xq = pack8(a, b); *(GAS bf16x8*)(xr + 32 * s) = xq; const v4u q2 = __builtin_bit_cast(v4u, xq); xqb[s] = xq;
              a = (f32x4){bflo(q2.x), bfhi(q2.x), bflo(q2.y), bfhi(q2.y)}; b = (f32x4){bflo(q2.z), bfhi(q2.z), bflo(q2.w), bfhi(q2.w)}; }
            ss += (a[0] * a[0] + a[1] * a[1]) + (a[2] * a[2] + a[3] * a[3]) + (b[0] * b[0] + b[1] * b[1]) + (b[2] * b[2] + b[3] * b[3]); }
        ss += shx(ss, 16, lane); ss += shx(ss, 32, lane);
        f32x4 acc[2] = {{0.f, 0.f, 0.f, 0.f}, {0.f, 0.f, 0.f, 0.f}};
#pragma unroll
        for (int s = 0; s < 4; ++s)
#pragma unroll
            for (int nf = 0; nf < 2; ++nf) acc[nf] = MFMA16(xqb[s], wf[s][nf], acc[nf]);
        __syncthreads();
        if (fq == 0) ssp[w * 16 + fr] = ss;
#pragma unroll
        for (int nf = 0; nf < 2; ++nf)
#pragma unroll
            for (int rg = 0; rg < 4; ++rg) Lp[(w * 16 + 4 * fq + rg) * 33 + 16 * nf + fr] = acc[nf][rg];
        __syncthreads();
        { const int tk = tid >> 5, n = tid & 31; float v = 0.f, tot = 0.f;
#pragma unroll
          for (int q = 0; q < 8; ++q) { v += Lp[(q * 16 + tk) * 33 + n]; tot += ssp[q * 16 + tk]; }
          const float r = rsqrtf(tot * (1.f / D) + RMS_EPS);
          GATES[(size_t)n * T + (size_t)it * 16 + tk] = v * r + gate_bias[n];
          if (n == 0) RS[it * 16 + tk] = r; }
    }
}
__device__ __forceinline__ void thin_weights(Frame& F, const float* w_rg, const float* w_re, const float* od_w_in, const float* od_gain, const float* moe_gain, bf16* WR, bf16* WGt, int wg, int nwg) {
    const int gt = wg * 512 + F.tid, NT = nwg * 512;
    for (int i = gt; i < 2 * 48 * 1024; i += NT) { const int k = i & 1023, n = (i >> 10) % 48, l = i / (48 * 1024);
        const float v = n < 4 ? w_rg[((size_t)l * D + k) * 4 + n] : (n < 36 ? w_re[((size_t)l * D + k) * 32 + n - 4] : 0.f);
        WR[i] = (bf16)f2bf(v * moe_gain[(size_t)l * D + k]); }
    for (int i = gt; i < 32 * 1024; i += NT) { const int k = i & 1023, n = i >> 10; WGt[i] = (bf16)f2bf(od_w_in[(size_t)k * OD_IN + OD_INP + n] * od_gain[k]); }
}

__device__ __forceinline__ const void* karg_ptr(int byte_off) {
    const void* r; const char* ks = (const char*)__builtin_amdgcn_kernarg_segment_ptr();
    asm volatile("s_load_dwordx2 %0, %1, %2\n\ts_waitcnt lgkmcnt(0)" : "=s"(r) : "s"(ks), "i"(byte_off) : "memory");
    return r;
}
#define KIN(i) ((const float*)karg_ptr(8 * (i)))
#define KOUT() ((float*)karg_ptr(160))
#define KWS() ((unsigned char*)karg_ptr(168))

__global__ void __launch_bounds__(512, 2) mk_fwd(Args args) {
    extern __shared__ __attribute__((aligned(16))) unsigned char lds_raw[];
    {   LAS unsigned char* l0 = (LAS unsigned char*)lds_raw;
        for (int u = threadIdx.x; u < (LDS_BYTES - LDSCTL_OFF) / 4; u += 512) ((LAS unsigned*)(l0 + LDSCTL_OFF))[u] = 0u;
        __syncthreads();
        if (!MK_PER_PHASE) (void)xcd_barrier_post((unsigned*)(KWS() + WS_CTL) + CW_BAR, (volatile LAS unsigned*)(l0 + MISC_OFF) + 8); }
    const int hi = args.ph_hi;
    const int wv0 = __builtin_amdgcn_readfirstlane((int)(threadIdx.x >> 6));
#ifdef ONLY
#define CASE(k) case (k): if ((k) != ONLY) break;
#define CASE2(a, b) case (a): case (b): if ((a) != ONLY) break;
#else
#define CASE(k) case (k):
#define CASE2(a, b) case (a): case (b):
#endif

    int redo = 0, pass = 0;
#ifndef PROBE_PREFIX
#define PROBE_PREFIX (-1)
#endif
    const int nsteps = hi + ((PROBE_PREFIX >= 0 && !MK_PER_PHASE) ? PROBE_PREFIX + 1 : 0);
#pragma unroll 1
    for (int step = args.ph_lo; step < nsteps; ++step) {
        int ph = step; if (step >= hi) { ph = step - hi; pass = 1; }
        Frame F;
        { int mb; asm volatile("v_mbcnt_lo_u32_b32 %0, -1, 0\n\tv_mbcnt_hi_u32_b32 %0, -1, %0" : "=v"(mb));
          int t = wv0 * 64 + mb; asm volatile("" : "+v"(t)); int bx = blockIdx.x, G = gridDim.x; asm volatile("" : "+s"(bx), "+s"(G));
          F.lds = (LAS unsigned char*)lds_raw; F.MISC = (volatile LAS unsigned*)(F.lds + MISC_OFF);
          F.tid = t; F.lane = t & 63; F.wave = __builtin_amdgcn_readfirstlane(t >> 6); F.G = G; F.vcu = (G % 8 == 0) ? (bx % 8) * (G / 8) + bx / 8 : bx; F.bx = bx; }
        LAS float* cs = (LAS float*)(F.lds + 100000);
        unsigned char* ws = KWS();
        const int layer = ph >= 14 ? 1 : 0;
        unsigned* cnt = (unsigned*)(ws + WS_CTL) + CW_CNT + ((layer * 2 + pass) * 32) * 64;
        switch (ph) {
        CASE(0) {
            convert_weights(F, KIN(2), 1024, 2048, 2048, 0, (bf16*)(ws + WS_WEVIN), 0, 1, -1, 0, KIN(1));
            const float* x = KIN(0); bf16* XN = (bf16*)(ws + WS_XN); float* RS = (float*)(ws + WS_DN);
            for (int m = F.vcu * 8 + F.wave; m < T; m += 4 * F.G * 8) { size_t ro[4];
#pragma unroll
                for (int r = 0; r < 4; ++r) { const int mr = m + r * F.G * 8; ro[r] = (size_t)(mr < T ? mr : m) * D; }
                rms_rows4_to_bf16(F.lane, x, ro, RS, XN); }
            if (F.bx == 0) ((unsigned*)(XN + (size_t)T * D))[F.tid] = 0u;
            if (F.bx == 1 || F.G == 1) ((unsigned*)((bf16*)(ws + WS_X1) + (size_t)T * D))[F.tid] = 0u;
        } break;
        CASE(1) {
#ifndef MK_CONV_DIV
#define MK_CONV_DIV 2
#define MK_CONV_NUM 1
#endif
            if ((F.vcu % MK_CONV_DIV) < MK_CONV_NUM) { const int cgw = ((F.vcu / MK_CONV_DIV) * MK_CONV_NUM + (F.vcu % MK_CONV_DIV)) * 8 + F.wave, cn = ((F.G / MK_CONV_DIV) * MK_CONV_NUM + min(F.G % MK_CONV_DIV, MK_CONV_NUM)) * 8;
                { const ConvSeg sg[6] = { {KIN(6), (bf16*)(ws + WS_WEVOUT), 1024, 1024, 1024, 1, 0, 0, nullptr},
                                          {KIN(17), (bf16*)(ws + WS_WG), 1024, 512, 512, 32, (size_t)1024 * 512, (size_t)512 * 1024, KIN(12)},
                                          {KIN(18), (bf16*)(ws + WS_WU), 1024, 512, 512, 32, (size_t)1024 * 512, (size_t)512 * 1024, KIN(12)},
                                          {KIN(19), (bf16*)(ws + WS_WD), 512, 1024, 1024, 32, (size_t)512 * 1024, (size_t)1024 * 512, nullptr},
                                          {KIN(8), (bf16*)(ws + WS_WODIN), 1024, 3072, OD_IN, 1, 0, 0, KIN(7)},
                                          {KIN(11), (bf16*)(ws + WS_WODOUT), 1024, 1024, 1024, 1, 0, 0, nullptr} };
                  convert_multi<6>(F, sg, cgw, cn); }
                thin_weights(F, KIN(13), KIN(15), KIN(8), KIN(7), KIN(12), (bf16*)(ws + WS_WR), (bf16*)(ws + WS_WGT), (F.vcu / MK_CONV_DIV) * MK_CONV_NUM + (F.vcu % MK_CONV_DIV), (F.G / MK_CONV_DIV) * MK_CONV_NUM + min(F.G % MK_CONV_DIV, MK_CONV_NUM));
                __syncthreads(); }
            ProbDenseDyn P; P.K = 1024; P.A = (const char*)(ws + WS_XN); P.Bt = (const char*)(ws + WS_WEVIN); P.ord.init(T, EV_IN, F.G, F.bx); P.bhalf_rows = 32;
            P.head = (unsigned*)(ws + WS_CTL) + CW_QDENSE + ((0 * 2 + pass) * 8) * 64; P.slot = (LAS int*)(F.lds + MOE_SLOT_OFF + 32); P.xlab = F.bx & 7;
            EpiEvIn E{(bf16*)(ws + WS_U), KIN(3), KIN(4), (const float*)(ws + WS_DN)};
            pg8::gemm_phase(F.lds, P, E, F.tid);
        } break;
        CASE(2) {
            na_mfma(F, (const bf16*)(ws + WS_U), KIN(5), (bf16*)(ws + WS_MIX));
            __syncthreads();
            if (F.tid < 64) { float sn, c; __sincosf(6.283185307179586f * (float)F.tid * (1.f / 64.f), &sn, &c); cs[F.tid] = c; cs[64 + F.tid] = sn; }
            __syncthreads();
            fourier1_mfma(F, (const bf16*)(ws + WS_U), (bf16*)(ws + WS_Y2), cs);
        } break;
        CASE(3) {
            if (F.tid < 64) { float sn, c; __sincosf(6.283185307179586f * (float)F.tid * (1.f / 64.f), &sn, &c); cs[F.tid] = c; cs[64 + F.tid] = sn; }
            __syncthreads();
            fourier2_mfma(F, (const bf16*)(ws + WS_Y2), (bf16*)(ws + WS_MIX), cs);
        } break;
        CASE(4) {
            ProbDense P; P.K = 1024; P.A = (const char*)(ws + WS_MIX); P.Bt = (const char*)(ws + WS_WEVOUT); P.ord.init(T, D, F.G, F.bx); P.bhalf_rows = 32;
            EpiResidB E{(const bf16*)(ws + WS_XN), (bf16*)(ws + WS_X1)};
            pg8::gemm_phase(F.lds, P, E, F.tid);
        } break;
        CASE2(5, 14) {
            router_mfma<true, false>(F, (const void*)(ws + WS_X1), (bf16*)(ws + WS_X1), KIN(12) + layer * D, (const bf16*)(ws + WS_WR) + (size_t)layer * 48 * 1024, KIN(14) + layer * 4, KIN(16) + layer * 32,
                        (const bf16*)(ws + WS_XN), (float*)(ws + WS_GATES), (int*)(ws + WS_ROUTE), (float*)(ws + WS_ROUTE + 256 * 1024), (int*)(ws + WS_ROUTE + 512 * 1024), cnt, (int*)(ws + WS_LIST));
        } break;
        CASE2(6, 15) {
            moe_tables(F.lds, cnt, F.tid);
            unsigned* ctlw = (unsigned*)(ws + WS_CTL);
            { ProbMoe1 P; P.K = 1024; P.A = (const char*)(ws + WS_X1); P.Wg = (const char*)(ws + WS_WG); P.Wu = (const char*)(ws + WS_WU); P.list = (const int*)(ws + WS_LIST);
              P.mt.tab = (LAS const int*)(F.lds + MOE_TAB_OFF); P.mt.head = ctlw + CW_QHEAD + ((layer * 2) * 2 + pass) * 64; P.mt.done = ctlw + CW_DONE + (layer * 2 + pass) * 256 * 64; P.mt.slot = (LAS int*)(F.lds + MOE_SLOT_OFF); P.mt.lane = F.lane;
              EpiMoe1 E{(bf16*)(ws + WS_H), (LAS const float*)(F.lds + pg8::RS_TAB_OFF)}; P.RSs = (const float*)(ws + WS_GATES);
              pg8::gemm_phase(F.lds, P, E, F.tid); }
            __syncthreads();
            { ProbMoe2 P; P.K = 512; P.A = (const char*)(ws + WS_H); P.Wd = (const char*)(ws + WS_WD);
              P.mt.tab = (LAS const int*)(F.lds + MOE_TAB_OFF); P.mt.head = ctlw + CW_QHEAD + ((layer * 2 + 1) * 2 + pass) * 64; P.mt.done = ctlw + CW_DONE + (layer * 2 + pass) * 256 * 64; P.mt.slot = (LAS int*)(F.lds + MOE_SLOT_OFF + 16); P.mt.lane = F.lane;
              EpiBf16Plain E{(bf16*)(ws + WS_Y), D, 0, 0, 1.f, nullptr, 0, 1 << 30};
              int tid2 = F.tid; asm volatile("" : "+v"(tid2));
              pg8::gemm_phase(F.lds, P, E, tid2); }
        } break;
        CASE2(7, 16) { } break;
        CASE(8) {
            const int* eid = (const int*)(ws + WS_ROUTE); const float* gate = (const float*)(ws + WS_ROUTE + 256 * 1024); const int* rel = (const int*)(ws + WS_ROUTE + 512 * 1024);
            moe_tables(F.lds, cnt, F.tid);
            combine_gates_mfma(F, (bf16*)(ws + WS_X1), (const bf16*)(ws + WS_Y), eid, gate, rel, (float*)(ws + WS_DN), (const bf16*)(ws + WS_WGT), KIN(9), (float*)(ws + WS_GATES));
        } break;
        CASE(17) {
            const int* eid = (const int*)(ws + WS_ROUTE); const float* gate = (const float*)(ws + WS_ROUTE + 256 * 1024); const int* rel = (const int*)(ws + WS_ROUTE + 512 * 1024);
            moe_tables(F.lds, cnt, F.tid);
            final_combine(F, (const bf16*)(ws + WS_X1), (const bf16*)(ws + WS_Y), eid, gate, rel, KOUT());
        } break;
        CASE(9) {
            if ((F.vcu % MK_CONV_DIV) < MK_CONV_NUM) { const int cgw = ((F.vcu / MK_CONV_DIV) * MK_CONV_NUM + (F.vcu % MK_CONV_DIV)) * 8 + F.wave, cn = ((F.G / MK_CONV_DIV) * MK_CONV_NUM + min(F.G % MK_CONV_DIV, MK_CONV_NUM)) * 8;
                { const ConvSeg sg[3] = { {KIN(17) + (size_t)32 * 1024 * 512, (bf16*)(ws + WS_WG), 1024, 512, 512, 32, (size_t)1024 * 512, (size_t)512 * 1024, KIN(12) + D},
                                          {KIN(18) + (size_t)32 * 1024 * 512, (bf16*)(ws + WS_WU), 1024, 512, 512, 32, (size_t)1024 * 512, (size_t)512 * 1024, KIN(12) + D},
                                          {KIN(19) + (size_t)32 * 512 * 1024, (bf16*)(ws + WS_WD), 512, 1024, 1024, 32, (size_t)512 * 1024, (size_t)1024 * 512, nullptr} };
                  convert_multi<3>(F, sg, cgw, cn); }
                __syncthreads(); }
            ProbDenseDyn P; P.K = 1024; P.A = (const char*)(ws + WS_X1); P.Bt = (const char*)(ws + WS_WODIN); P.ord.init(T, OD_INP, F.G, F.bx); P.bhalf_rows = 32;
            P.head = (unsigned*)(ws + WS_CTL) + CW_QDENSE + ((1 * 2 + pass) * 8) * 64; P.slot = (LAS int*)(F.lds + MOE_SLOT_OFF + 32); P.xlab = F.bx & 7;
            EpiBf16Plain E{(bf16*)(ws + WS_U), PQK, 2, 4, 0.125f, (bf16*)(ws + WS_U) + VO_OFF, PVO, 4, (const float*)(ws + WS_DN)};
            pg8::gemm_phase(F.lds, P, E, F.tid);
        } break;
        CASE(10) { float* SCg = (float*)(ws + WS_SC);
            m1_mfma(F, (const bf16*)(ws + WS_U), (const float*)(ws + WS_GATES), (bf16*)(ws + WS_DC), (float*)(ws + WS_DN), SCg, SCg + 4096); } break;
        CASE(11) { float* SCg = (float*)(ws + WS_SC);
            m2_phase(F, (const bf16*)(ws + WS_DC), (bf16*)(ws + WS_CP), (const float*)(ws + WS_DN), (float*)(ws + WS_NPREV), SCg, SCg + 4096, SCg + 8192); } break;
        CASE(12) { float* SCg = (float*)(ws + WS_SC);
            m3_mfma(F, (const bf16*)(ws + WS_U), (const float*)(ws + WS_GATES), (const bf16*)(ws + WS_CP), (const float*)(ws + WS_NPREV), SCg + 8192, KIN(10), (bf16*)(ws + WS_Y2)); } break;
        CASE(13) {
            ProbDense P; P.K = 1024; P.A = (const char*)(ws + WS_Y2); P.Bt = (const char*)(ws + WS_WODOUT); P.ord.init(T, D, F.G, F.bx); P.bhalf_rows = 32;
            EpiResidB E{(const bf16*)(ws + WS_X1), (bf16*)(ws + WS_X1)};
            pg8::gemm_phase(F.lds, P, E, F.tid);
        } break;
        default: break;
        }
        if (step + 1 < nsteps && ph != 6 && ph != 15) { XcdBarrier bar; bar.bar = (unsigned*)(KWS() + WS_CTL) + CW_BAR; bar.x = xb_xcc_id(); bar.st = (volatile LAS unsigned*)((LAS unsigned char*)lds_raw + MISC_OFF) + 8; xcd_barrier(bar); }
        if (PROBE_REP) { if (((PROBE_REP >> ph) & 1u) && !redo) { redo = 1; --step; } else redo = 0; }
    }
#undef CASE
#undef CASE2
}

extern "C" void kernel_launch(void* const* d_in, const int* in_sizes, int n_in, void* d_out, int out_size, void* d_ws, size_t ws_size, hipStream_t stream) {
    static int grid = 0;
    if (grid == 0) {
        if (n_in != 20 || in_sizes[0] != T * D || out_size != T * D || ws_size < WS_END) { fprintf(stderr, "kernel_launch: unexpected shapes (n_in %d, in0 %d, out %d, ws %zu < %zu)\n", n_in, n_in > 0 ? in_sizes[0] : -1, out_size, ws_size, (size_t)WS_END); grid = -1; return; }
        int dev = 0, cus = 0, per_cu = 0;
        if (hipGetDevice(&dev) != hipSuccess || hipDeviceGetAttribute(&cus, hipDeviceAttributeMultiprocessorCount, dev) != hipSuccess) { grid = -1; return; }
        if (hipFuncSetAttribute((const void*)mk_fwd, hipFuncAttributeMaxDynamicSharedMemorySize, LDS_BYTES) != hipSuccess) { fprintf(stderr, "kernel_launch: hipFuncSetAttribute failed\n"); grid = -1; return; }
        if (hipOccupancyMaxActiveBlocksPerMultiprocessor(&per_cu, (const void*)mk_fwd, 512, LDS_BYTES) != hipSuccess || per_cu < 1) { fprintf(stderr, "kernel_launch: occupancy query reports %d\n", per_cu); }
        (void)hipGetLastError();
        grid = cus;
    }
    if (grid < 0) return;
    if (hipMemsetAsync((char*)d_ws + WS_CTL, 0, CTL_ZERO_BYTES, stream) != hipSuccess) return;
    Args a{};
    for (int i = 0; i < 20; ++i) a.in[i] = (const float*)d_in[i];
    a.out = (float*)d_out; a.ws = (unsigned char*)d_ws;
#if MK_PER_PHASE
    for (int p = 0; p < NPH; ++p) { a.ph_lo = p; a.ph_hi = p + 1; hipLaunchKernelGGL(mk_fwd, dim3(grid), dim3(512), LDS_BYTES, stream, a); }
#else
    a.ph_lo = 0; a.ph_hi = NPH;
    hipLaunchKernelGGL(mk_fwd, dim3(grid), dim3(512), LDS_BYTES, stream, a);
#endif
}
```
